# Optimizing an MI355X kernel written in HIP

```python
import jax, jax.numpy as jnp
from jax import lax
import numpy as np

D_MODEL = 1024
BATCH = 4
SEQ = 4096
DEPTH = 2
DEC_BATCH = 128
DEC_SEQ = 8
PAST_LEN = 8192
PAGE_SIZE = 128

D_MIX = D_MODEL
CONV_W = D_MIX // 2
CONV_K = 3
HEAD_DIM = 64
N_HEADS = (D_MIX - CONV_W) // HEAD_DIM
N_KV_HEADS = 2
GQA_G = N_HEADS // N_KV_HEADS
WINDOW = 128
BLOCK = 128
ROT_DIM = HEAD_DIM // 4
ROPE_THETA = 500000.0
EPS = 1e-6
ATTN_W = N_HEADS * HEAD_DIM
KV_W = N_KV_HEADS * HEAD_DIM
PROJ_SIZES = [CONV_W, CONV_W, CONV_W, CONV_W, ATTN_W, KV_W, KV_W, ATTN_W]
PROJ_OUT = sum(PROJ_SIZES)
PROJ_SPLITS = list(np.cumsum(PROJ_SIZES)[:-1].tolist())
NEG = -1e30

kernel_name = "hymba_conv_swa_adaln_decoder_step"


def rmsnorm(x, g):
    x32 = x.astype(jnp.float32)
    y = x32 * lax.rsqrt(jnp.mean(x32 * x32, axis=-1, keepdims=True) + EPS)
    return (y * g.astype(jnp.float32)).astype(x.dtype)


def rope_partial(x, pos):
    inv_freq = ROPE_THETA ** (-jnp.arange(0, ROT_DIM, 2, dtype=jnp.float32) / ROT_DIM)
    ang = pos[:, None] * inv_freq[None, :]
    cos = jnp.cos(ang)[None, :, None, :].astype(x.dtype)
    sin = jnp.sin(ang)[None, :, None, :].astype(x.dtype)
    xr, xp = x[..., :ROT_DIM], x[..., ROT_DIM:]
    x1, x2 = jnp.split(xr, 2, axis=-1)
    return jnp.concatenate([x1 * cos - x2 * sin, x2 * cos + x1 * sin, xp], axis=-1)


def sink_probs(s, sink, mask):
    s = jnp.where(mask, s, NEG)
    sk = sink.astype(jnp.float32)[:, :, None]
    m = jnp.maximum(jnp.max(s, axis=-1), sk)
    p = jnp.exp(s - m[..., None])
    denom = jnp.sum(p, axis=-1) + jnp.exp(sk - m)
    return p / denom[..., None]


def window_attn_prompt(q, k, v, sink):
    N, L = q.shape[0], q.shape[1]
    nb = L // BLOCK
    qb = q.astype(jnp.float32).reshape(N, nb, BLOCK, N_KV_HEADS, GQA_G, HEAD_DIM)
    pad = ((0, 0), (BLOCK, 0), (0, 0), (0, 0))
    kp = jnp.pad(k.astype(jnp.float32), pad).reshape(N, nb + 1, BLOCK, N_KV_HEADS, HEAD_DIM)
    vp = jnp.pad(v.astype(jnp.float32), pad).reshape(N, nb + 1, BLOCK, N_KV_HEADS, HEAD_DIM)
    kb = jnp.concatenate([kp[:, :-1], kp[:, 1:]], axis=2)
    vb = jnp.concatenate([vp[:, :-1], vp[:, 1:]], axis=2)
    s = jnp.einsum('nbqkgd,nbskd->nbkgqs', qb, kb) * (HEAD_DIM ** -0.5)
    qi = jnp.arange(BLOCK)[:, None] + BLOCK
    kj = jnp.arange(2 * BLOCK)[None, :]
    blk = jnp.arange(nb)[:, None, None]
    mask = (kj <= qi) & (kj > qi - WINDOW)
    mask = mask[None] & (blk * BLOCK + kj[None] - BLOCK >= 0)
    p = sink_probs(s, sink.reshape(N_KV_HEADS, GQA_G), mask[None, :, None, None])
    o = jnp.einsum('nbkgqs,nbskd->nbqkgd', p, vb)
    return o.reshape(N, L, ATTN_W)


def window_attn_cached(q, k_ext, v_ext, sink):
    N, L = q.shape[0], q.shape[1]
    Wb = k_ext.shape[1] - L
    qg = q.astype(jnp.float32).reshape(N, L, N_KV_HEADS, GQA_G, HEAD_DIM)
    s = jnp.einsum('nqkgd,nskd->nkgqs', qg, k_ext.astype(jnp.float32)) * (HEAD_DIM ** -0.5)
    qi = Wb + jnp.arange(L)[:, None]
    kj = jnp.arange(Wb + L)[None, :]
    mask = (kj <= qi) & (kj > qi - WINDOW)
    p = sink_probs(s, sink.reshape(N_KV_HEADS, GQA_G), mask)
    o = jnp.einsum('nkgqs,nskd->nqkgd', p, v_ext.astype(jnp.float32))
    return o.reshape(N, L, ATTN_W)


def layer(x, c, pos, conv_prev, k_prev, v_prev, w_mod, b_mod, norm_g, w_in, conv_w,
          q_norm_g, k_norm_g, sink, w_out):
    N, L, _ = x.shape
    mod = jax.nn.silu(c) @ w_mod + b_mod
    shift, scale, gate = jnp.split(mod, 3, axis=-1)
    h = rmsnorm(x, norm_g) * (1.0 + scale[:, None]) + shift[:, None]
    proj = h @ w_in
    gb, gc, hc, zc, q, k, v, za = jnp.split(proj, PROJ_SPLITS, axis=-1)

    u = gc * hc
    if conv_prev is None:
        conv_prev = jnp.zeros((N, CONV_K - 1, CONV_W), u.dtype)
    u_ext = jnp.concatenate([conv_prev.astype(u.dtype), u], axis=1)
    conv = sum(u_ext[:, i:i + L] * conv_w[i] for i in range(CONV_K))
    y_conv = gb * conv * jax.nn.silu(zc)
    new_conv = u_ext[:, -(CONV_K - 1):]

    q = rope_partial(rmsnorm(q.reshape(N, L, N_HEADS, HEAD_DIM), q_norm_g), pos)
    k = rope_partial(rmsnorm(k.reshape(N, L, N_KV_HEADS, HEAD_DIM), k_norm_g), pos)
    v = v.reshape(N, L, N_KV_HEADS, HEAD_DIM)
    if k_prev is None:
        attn = window_attn_prompt(q, k, v, sink)
        keep = min(WINDOW, L)
        new_k, new_v = k[:, -keep:], v[:, -keep:]
    else:
        Wb = k_prev.shape[1]
        k_ext = jnp.concatenate([k_prev.astype(k.dtype), k], axis=1)
        v_ext = jnp.concatenate([v_prev.astype(v.dtype), v], axis=1)
        attn = window_attn_cached(q, k_ext, v_ext, sink)
        new_k, new_v = k_ext[:, -Wb:], v_ext[:, -Wb:]
    y_attn = attn.astype(x.dtype) * jax.nn.silu(za)

    out = jnp.concatenate([y_conv, y_attn], axis=-1) @ w_out
    return x + gate[:, None] * out, new_conv, new_k, new_v


def setup_inputs(seed: int = 0) -> dict:
    key = jax.random.key(seed)
    ks = jax.random.split(key, 16)
    kv_buf = min(WINDOW, PAST_LEN)
    f32 = jnp.float32
    return {
        "x_prompt": jax.random.normal(ks[0], (BATCH, SEQ, D_MODEL), f32),
        "x_sample": jax.random.normal(ks[1], (DEC_BATCH, DEC_SEQ, D_MODEL), f32),
        "c_prompt": jax.random.normal(ks[2], (BATCH, D_MODEL), f32),
        "c_sample": jax.random.normal(ks[3], (DEC_BATCH, D_MODEL), f32),
        "state_conv": jax.random.normal(ks[4], (DEPTH, DEC_BATCH, CONV_K - 1, CONV_W), f32),
        "cache_k_win": jax.random.normal(ks[5], (DEPTH, DEC_BATCH, kv_buf, N_KV_HEADS, HEAD_DIM), f32),
        "cache_v_win": jax.random.normal(ks[6], (DEPTH, DEC_BATCH, kv_buf, N_KV_HEADS, HEAD_DIM), f32),
        "w_mod": jax.random.normal(ks[7], (DEPTH, D_MODEL, 3 * D_MODEL), f32) * (0.5 * D_MODEL ** -0.5),
        "b_mod": jax.random.normal(ks[8], (DEPTH, 3 * D_MODEL), f32) * 0.01,
        "norm_g": 1.0 + 0.02 * jax.random.normal(ks[9], (DEPTH, D_MODEL), f32),
        "w_in": jax.random.normal(ks[10], (DEPTH, D_MODEL, PROJ_OUT), f32) * D_MODEL ** -0.5,
        "conv_w": jax.random.normal(ks[11], (DEPTH, CONV_K, CONV_W), f32) * CONV_K ** -0.5,
        "q_norm_g": 1.0 + 0.02 * jax.random.normal(ks[12], (DEPTH, HEAD_DIM), f32),
        "k_norm_g": 1.0 + 0.02 * jax.random.normal(ks[13], (DEPTH, HEAD_DIM), f32),
        "sinks": jax.random.normal(ks[14], (DEPTH, N_HEADS), f32) * 0.5,
        "w_out": jax.random.normal(ks[15], (DEPTH, D_MIX, D_MODEL), f32) * D_MIX ** -0.5,
    }


def reference(x_prompt, x_sample, c_prompt, c_sample, state_conv, cache_k_win, cache_v_win,
              w_mod, b_mod, norm_g, w_in, conv_w, q_norm_g, k_norm_g, sinks, w_out):
    L_p = x_prompt.shape[1]
    L_s = x_sample.shape[1]
    past = PAST_LEN
    pos_p = jnp.arange(L_p, dtype=jnp.float32)
    pos_s = past + jnp.arange(L_s, dtype=jnp.float32)
    hp, hs = x_prompt, x_sample
    conv_p, k_p, v_p, conv_s, k_s, v_s = [], [], [], [], [], []
    for l in range(DEPTH):
        w = (w_mod[l], b_mod[l], norm_g[l], w_in[l], conv_w[l], q_norm_g[l], k_norm_g[l],
             sinks[l], w_out[l])
        hp, cp, kp, vp = layer(hp, c_prompt, pos_p, None, None, None, *w)
        hs, cs, ksn, vsn = layer(hs, c_sample, pos_s, state_conv[l], cache_k_win[l],
                                 cache_v_win[l], *w)
        conv_p.append(cp); k_p.append(kp); v_p.append(vp)
        conv_s.append(cs); k_s.append(ksn); v_s.append(vsn)
    return (hp, hs, jnp.stack(conv_p), jnp.stack(k_p), jnp.stack(v_p),
            jnp.stack(conv_s), jnp.stack(k_s), jnp.stack(v_s))
```

```cpp
#include <hip/hip_runtime.h>
#include <hip/hip_cooperative_groups.h>
#include <cstdio>
#include <cstdint>
namespace cg = cooperative_groups;
#ifndef DUP
#define DUP 0
#endif
namespace pg8 {
#define PG8_LAS __attribute__((address_space(3)))
typedef unsigned short bf16_t;
typedef short bf16x8 __attribute__((ext_vector_type(8)));
typedef float f32x4 __attribute__((ext_vector_type(4)));
typedef unsigned u32x4 __attribute__((ext_vector_type(4)));
constexpr int BM = 256, BK = 64, HALF = 128, HTB = HALF * BK * 2  , STAGE_BYTES = 8 * HTB, NXCD = 8, WGM = 8;

__host__ __device__ __forceinline__ int lds_byte(int r, int c) { const int st = (r >> 4) * 2 + (c >> 5), rr = r & 15, cc = c & 31, ob = rr * 64 + cc * 2; return st * 1024 + (ob ^ (((ob >> 9) & 1) << 5)); }
__host__ __device__ __forceinline__ void stage_rc(int b, int& R, int& C) { const int st = b / 1024, sb = b % 1024, swz = sb ^ (((sb >> 9) & 1) << 5); R = (st >> 1) * 16 + swz / 64; C = (st & 1) * 32 + (swz % 64) / 2; }
__host__ __device__ __forceinline__ int perm32(int rho) { const int n = rho >> 4, i = rho & 15; return 8 * (i >> 2) + 4 * n + (i & 3); }

struct Unit { int pm, pn; };
struct Gemm { const bf16_t* A; const bf16_t* Bt; int M, N, K; };

struct StaticOrder {
    int nM, nN, nwg, G, c;
    __host__ __device__ void init(int M, int N, int G_, int c_) { nM = M / BM; nN = N / BM; nwg = nM * nN; G = G_; c = c_; }
    __host__ __device__ bool next(int i, Unit& u) const {
        const long L = (long)i * G + c; if (L >= nwg) return false;
        int wgid = (int)L; { const int q = nwg / NXCD, r = nwg % NXCD, xcd = wgid % NXCD, off = wgid / NXCD; wgid = (xcd < r ? xcd * (q + 1) : r * (q + 1) + (xcd - r) * q) + off; }
        const int nig = WGM * nN, gid = wgid / nig, fm = gid * WGM, gsz = (nM - fm) < WGM ? (nM - fm) : WGM;
        u.pm = fm + ((wgid % nig) % gsz); u.pn = (wgid % nig) / gsz; return true;
    }
    __device__ __forceinline__ void a_ready(const Unit&) const {}
    __device__ __forceinline__ void done(const Unit&) const {}
};

__device__ __forceinline__ unsigned cvt_pk_bf16(float lo, float hi) { unsigned r; asm volatile("v_cvt_pk_bf16_f32 %0, %1, %2" : "=v"(r) : "v"(lo), "v"(hi)); return r; }
typedef float f32x2 __attribute__((ext_vector_type(2)));
__device__ __forceinline__ f32x2 gelu_pk(f32x2 v) {
    const f32x2 av = __builtin_elementwise_abs(v), d = av * 0.2316418882f + 1.0f;
    f32x2 t; t.x = __builtin_amdgcn_rcpf(d.x); t.y = __builtin_amdgcn_rcpf(d.y);
    f32x2 q = t * 0.5307027145f + (-0.7265760135f); q = q * t + 0.7107068705f; q = q * t + (-0.142248368f); q = q * t + 0.127414796f; q = q * t;
    const f32x2 s = (v * v) * (-0.72134752044f);
    f32x2 e; e.x = __builtin_amdgcn_exp2f(s.x); e.y = __builtin_amdgcn_exp2f(s.y);
    const f32x2 m = v * (q * e), r = v - m;
    f32x2 o; o.x = v.x < 0.f ? m.x : r.x; o.y = v.y < 0.f ? m.y : r.y; return o;
}

template <int ACT  > struct EpiBf16 {
    static constexpr bool PERM = true, AFTER_DRAIN = false; static_assert(ACT == 0 || ACT == 1, "EpiBf16: ACT is 0 (none) or 1 (gelu_pk)");
    bf16_t* O; int ldc; const float* bias; int split_cols; size_t split_stride; float scale0;
    __device__ __forceinline__ void operator()(const f32x4 (&acc)[2][2][4][2], const Unit& u, int wr, int wc, int fr, int fq) const {
        const int row0 = u.pm * BM + wr * 64 + fr; int colt = u.pn * BM; bf16_t* base = O;
        float sc = 1.f; if (split_cols) { const int t = colt / split_cols; base += (size_t)t * split_stride; colt -= t * split_cols; if (t == 0) sc = scale0; }
        const int col0 = colt + wc * 32 + 8 * fq, bcol0 = u.pn * BM + wc * 32 + 8 * fq;
        f32x4 bv[2][2];
#pragma unroll
        for (int bj = 0; bj < 2; ++bj)
#pragma unroll
            for (int n = 0; n < 2; ++n) bv[bj][n] = bias ? *(const f32x4*)(bias + bcol0 + bj * HALF + 4 * n) : (f32x4){0.f, 0.f, 0.f, 0.f};
#pragma unroll
        for (int ai = 0; ai < 2; ++ai)
#pragma unroll
            for (int m = 0; m < 4; ++m) { bf16_t* rowp = base + (size_t)(row0 + ai * HALF + m * 16) * ldc + col0;
#pragma unroll
                for (int bj = 0; bj < 2; ++bj) { f32x4 v0 = acc[ai][bj][m][0] + bv[bj][0], v1 = acc[ai][bj][m][1] + bv[bj][1];
                    if (ACT == 1) { f32x2 a = gelu_pk((f32x2){v0[0], v0[1]}), b = gelu_pk((f32x2){v0[2], v0[3]}), c = gelu_pk((f32x2){v1[0], v1[1]}), d = gelu_pk((f32x2){v1[2], v1[3]});
                        v0 = (f32x4){a.x, a.y, b.x, b.y}; v1 = (f32x4){c.x, c.y, d.x, d.y}; }
                    v0 = v0 * sc; v1 = v1 * sc; u32x4 w; w.x = cvt_pk_bf16(v0[0], v0[1]); w.y = cvt_pk_bf16(v0[2], v0[3]); w.z = cvt_pk_bf16(v1[0], v1[1]); w.w = cvt_pk_bf16(v1[2], v1[3]);
                    *(u32x4*)(rowp + bj * HALF) = w; } }
    }
};
template <class Epi, class Sched, bool ALIGN_EPI = false, bool SP2 = false>
__device__ __forceinline__ void gemm_phase(PG8_LAS unsigned char* lds, const Gemm g, const Sched& S, const Epi& E) {
    int tid_ = threadIdx.x; asm volatile("" : "+v"(tid_));
    const int tid = tid_, wid = __builtin_amdgcn_readfirstlane(tid >> 6), lane = tid & 63, wr = wid >> 2, wc = wid & 3, fr = lane & 15, fq = lane >> 4;
    const int K = g.K, nt = K / BK;
    unsigned voffA[2], voffB[2];
#pragma unroll
    for (int i = 0; i < 2; ++i) { int R, C; stage_rc(tid * 16 + i * 8192, R, C); const int Rb = Epi::PERM ? ((R & ~31) + perm32(R & 31)) : R;
        voffA[i] = (unsigned)(R * K + C) * 2u; voffB[i] = (unsigned)(Rb * K + C) * 2u; }
    const size_t kstep = (size_t)(BK * 2);
    const size_t hstep = (size_t)HALF * K * 2;
    const size_t tstep = 2 * hstep;
    const unsigned ldsw = (unsigned)wid * 1024u;
    const int aoff = lds_byte(wr * 64 + fr, fq * 8), boff = lds_byte(wc * 32 + fr, fq * 8);
#define PG8_SA(b, h) (((b) * 2 + (h)) * HTB)
#define PG8_SB(b, h) ((4 + (b) * 2 + (h)) * HTB)
#define PG8_STAGE(bufoff, gbase, voff) do { _Pragma("unroll") for (int _i = 0; _i < 2; ++_i) \
        __builtin_amdgcn_global_load_lds((const unsigned*)((const char*)(gbase) + (voff)[_i]), (PG8_LAS unsigned*)(lds + (bufoff) + ldsw + _i * 8192), 16, 0, 0); } while (0)
#define PG8_LDA(dst, b, h) do { _Pragma("unroll") for (int m = 0; m < 4; ++m) _Pragma("unroll") for (int k = 0; k < 2; ++k) dst[m][k] = *(const PG8_LAS bf16x8*)(lds + PG8_SA(b, h) + aoff + m * 2048 + k * 1024); } while (0)
#define PG8_LDB(dst, b, h) do { _Pragma("unroll") for (int n = 0; n < 2; ++n) _Pragma("unroll") for (int k = 0; k < 2; ++k) dst[n][k] = *(const PG8_LAS bf16x8*)(lds + PG8_SB(b, h) + boff + n * 2048 + k * 1024); } while (0)
#define PG8_MMA(ai, bj, At, Bt) do { __builtin_amdgcn_s_setprio(1); _Pragma("unroll") for (int m = 0; m < 4; ++m) _Pragma("unroll") for (int n = 0; n < 2; ++n) _Pragma("unroll") for (int k = 0; k < 2; ++k) \
        acc[ai][bj][m][n] = __builtin_amdgcn_mfma_f32_16x16x32_bf16(Bt[n][k], At[m][k], acc[ai][bj][m][n], 0, 0, 0); __builtin_amdgcn_s_setprio(0); } while (0)
#define PG8_WAIT_V(n) asm volatile("s_waitcnt vmcnt(" #n ")" ::: "memory")
#define PG8_WAIT_L(n) asm volatile("s_waitcnt lgkmcnt(" #n ")" ::: "memory")
#define PG8_BAR __builtin_amdgcn_s_barrier()
#define PG8_SCHED __builtin_amdgcn_sched_barrier(0)
    Unit cur, nxt; int ui = 0;
    if (!S.next(0, cur)) return;
    f32x4 acc[2][2][4][2];
#pragma unroll
    for (int a = 0; a < 2; ++a)
#pragma unroll
        for (int b = 0; b < 2; ++b)
#pragma unroll
            for (int m = 0; m < 4; ++m)
#pragma unroll
                for (int n = 0; n < 2; ++n) acc[a][b][m][n] = (f32x4){0.f, 0.f, 0.f, 0.f};
    bf16x8 At[4][2], B0[2][2], B1[2][2];
    const char* cA = (const char*)g.A + (size_t)cur.pm * tstep; const char* cB = (const char*)g.Bt + (size_t)cur.pn * tstep;
    S.a_ready(cur);
    if constexpr (SP2) {
        PG8_STAGE(PG8_SB(0, 0), cB, voffB); PG8_STAGE(PG8_SB(0, 1), cB + hstep, voffB); PG8_STAGE(PG8_SA(0, 0), cA, voffA); PG8_STAGE(PG8_SA(0, 1), cA + hstep, voffA);
        if (wr == 1) PG8_BAR;
        PG8_WAIT_V(2); PG8_BAR;
        PG8_STAGE(PG8_SB(1, 0), cB + kstep, voffB); PG8_STAGE(PG8_SA(1, 0), cA + kstep, voffA); PG8_STAGE(PG8_SB(1, 1), cB + hstep + kstep, voffB);
        PG8_WAIT_V(6); PG8_BAR;
    } else {
        PG8_STAGE(PG8_SB(0, 0), cB, voffB); PG8_STAGE(PG8_SA(0, 0), cA, voffA); PG8_STAGE(PG8_SB(0, 1), cB + hstep, voffB); PG8_STAGE(PG8_SA(0, 1), cA + hstep, voffA);
        if (wr == 1) PG8_BAR;
        PG8_WAIT_V(4); PG8_BAR;
        PG8_STAGE(PG8_SB(1, 0), cB + kstep, voffB); PG8_STAGE(PG8_SA(1, 0), cA + kstep, voffA); PG8_STAGE(PG8_SB(1, 1), cB + hstep + kstep, voffB);
        PG8_WAIT_V(6); PG8_BAR;
    }
    for (;;) {
        const bool has_next = S.next(ui + 1, nxt);
        const char* nA = has_next ? (const char*)g.A + (size_t)nxt.pm * tstep : cA; const char* nB = has_next ? (const char*)g.Bt + (size_t)nxt.pn * tstep : cB;
        for (int t = 0; t < nt; t += 2) {
            const bool last = (t == nt - 2);
            const char* a1 = cA + (size_t)(t + 1) * kstep;
            const char* a2 = last ? nA : cA + (size_t)(t + 2) * kstep; const char* b2 = last ? nB : cB + (size_t)(t + 2) * kstep;
            const char* a3 = a2 + kstep; const char* b3 = b2 + kstep;
            if (last && has_next) S.a_ready(nxt);
            if constexpr (SP2) {
            PG8_LDB(B0, 0, 0); PG8_LDB(B1, 0, 1); PG8_SCHED; PG8_LDA(At, 0, 0); PG8_STAGE(PG8_SA(1, 1), a1 + hstep, voffA);
            PG8_WAIT_V(8); PG8_WAIT_L(0); PG8_BAR; PG8_MMA(0, 0, At, B0); PG8_MMA(0, 1, At, B1); PG8_BAR; PG8_SCHED;
            PG8_LDA(At, 0, 1); PG8_STAGE(PG8_SB(0, 0), b2, voffB); PG8_STAGE(PG8_SB(0, 1), b2 + hstep, voffB); PG8_STAGE(PG8_SA(0, 0), a2, voffA);
            PG8_WAIT_V(8); PG8_WAIT_L(0); PG8_BAR; PG8_MMA(1, 0, At, B0); PG8_MMA(1, 1, At, B1); PG8_BAR; PG8_SCHED;
            PG8_LDB(B0, 1, 0); PG8_LDB(B1, 1, 1); PG8_SCHED; PG8_LDA(At, 1, 0); PG8_STAGE(PG8_SA(0, 1), a2 + hstep, voffA);
            PG8_WAIT_V(8); PG8_WAIT_L(0); PG8_BAR; PG8_MMA(0, 0, At, B0); PG8_MMA(0, 1, At, B1); PG8_BAR; PG8_SCHED;
            PG8_LDA(At, 1, 1); PG8_STAGE(PG8_SB(1, 0), b3, voffB); PG8_STAGE(PG8_SB(1, 1), b3 + hstep, voffB); PG8_STAGE(PG8_SA(1, 0), a3, voffA);
            PG8_WAIT_V(8); PG8_WAIT_L(0); PG8_BAR; PG8_MMA(1, 0, At, B0); PG8_MMA(1, 1, At, B1); PG8_BAR; PG8_SCHED;
            } else {
            PG8_LDB(B0, 0, 0); PG8_SCHED; PG8_LDA(At, 0, 0); PG8_STAGE(PG8_SA(1, 1), a1 + hstep, voffA);
            PG8_WAIT_L(8); PG8_BAR; PG8_WAIT_L(0); PG8_MMA(0, 0, At, B0); PG8_BAR; PG8_SCHED;
            PG8_LDB(B1, 0, 1); PG8_STAGE(PG8_SB(0, 0), b2, voffB);
            PG8_BAR; PG8_WAIT_L(0); PG8_MMA(0, 1, At, B1); PG8_BAR;
            PG8_LDA(At, 0, 1); PG8_STAGE(PG8_SA(0, 0), a2, voffA);
            PG8_BAR; PG8_WAIT_L(0); PG8_MMA(1, 0, At, B0); PG8_BAR; PG8_SCHED;
            PG8_STAGE(PG8_SB(0, 1), b2 + hstep, voffB);
            PG8_WAIT_V(6); PG8_BAR; PG8_MMA(1, 1, At, B1); PG8_BAR;
            PG8_LDB(B0, 1, 0); PG8_SCHED; PG8_LDA(At, 1, 0); PG8_STAGE(PG8_SA(0, 1), a2 + hstep, voffA);
            PG8_WAIT_L(8); PG8_BAR; PG8_WAIT_L(0); PG8_MMA(0, 0, At, B0); PG8_BAR; PG8_SCHED;
            PG8_LDB(B1, 1, 1); PG8_STAGE(PG8_SB(1, 0), b3, voffB);
            PG8_BAR; PG8_WAIT_L(0); PG8_MMA(0, 1, At, B1); PG8_BAR;
            PG8_LDA(At, 1, 1); PG8_STAGE(PG8_SA(1, 0), a3, voffA);
            PG8_BAR; PG8_WAIT_L(0); PG8_MMA(1, 0, At, B0); PG8_BAR; PG8_SCHED;
            PG8_STAGE(PG8_SB(1, 1), b3 + hstep, voffB);
            PG8_WAIT_V(6); PG8_BAR; PG8_MMA(1, 1, At, B1); PG8_BAR;
            }
        }
        if constexpr (ALIGN_EPI) { if (wr == 0) PG8_BAR; }
        if constexpr (!Epi::AFTER_DRAIN) { E(acc, cur, wr, wc, fr, fq); S.done(cur); }
        if (!has_next) break;
#pragma unroll
        for (int a = 0; a < 2; ++a)
#pragma unroll
            for (int b = 0; b < 2; ++b)
#pragma unroll
                for (int m = 0; m < 4; ++m)
#pragma unroll
                    for (int n = 0; n < 2; ++n) acc[a][b][m][n] = (f32x4){0.f, 0.f, 0.f, 0.f};
        cur = nxt; cA = nA; cB = nB; ++ui;
        if constexpr (ALIGN_EPI) { if (wr == 1) PG8_BAR; }
    }
    PG8_WAIT_V(0);
    if constexpr (!ALIGN_EPI) { if (wr == 0) PG8_BAR; }
    PG8_BAR;
    if constexpr (Epi::AFTER_DRAIN) { E.fused(acc, cur, wr, wc, fr, fq, lds, wid, lane); S.done(cur); }
#undef PG8_SA
#undef PG8_SB
#undef PG8_STAGE
#undef PG8_LDA
#undef PG8_LDB
#undef PG8_MMA
#undef PG8_WAIT_V
#undef PG8_WAIT_L
#undef PG8_BAR
#undef PG8_SCHED
}
}

#define LAS __attribute__((address_space(3)))
typedef unsigned short bf16_t;
typedef float f32x4 __attribute__((ext_vector_type(4)));
typedef float f32x16 __attribute__((ext_vector_type(16)));
typedef unsigned u32x4 __attribute__((ext_vector_type(4)));
typedef unsigned u32x2 __attribute__((ext_vector_type(2)));
typedef short bf16x8 __attribute__((ext_vector_type(8)));
typedef short s16x4 __attribute__((ext_vector_type(4)));
typedef short v4i16_t __attribute__((ext_vector_type(4)));

constexpr int D = 1024, NPB = 4, LP = 4096, NSB = 128, LS = 8;
constexpr int MP = NPB * LP, MS = NSB * LS, M = MP + MS;
constexpr int PO = 3328;
constexpr int PO2 = 2304;
constexpr int C_U = 0, C_GZ = 512, C_Q = 1024, C_K = 1536, C_V = 1664, C_ZA = 1792;
constexpr int NMOD = NPB + NSB;
constexpr float EPS = 1e-6f;
constexpr float LOG2E = 1.4426950408889634f;
constexpr size_t O_YP = 0, O_YS = (size_t)MP * D, O_CP = O_YS + (size_t)MS * D, O_KP = O_CP + 2 * NPB * 2 * 512, O_VP = O_KP + 2 * NPB * 128 * 128,
                 O_CS = O_VP + 2 * NPB * 128 * 128, O_KS = O_CS + 2 * NSB * 2 * 512, O_VS = O_KS + (size_t)2 * NSB * 128 * 128, O_END = O_VS + (size_t)2 * NSB * 128 * 128;
static_assert(O_END == 26746880, "output size");
constexpr size_t MiB = 1u << 20;
constexpr size_t WS_WIN = 0, WS_WOUT = 14 * MiB, WS_MOD = 18 * MiB, WS_ROPE = 22 * MiB, WS_H = 24 * MiB, WS_PROJ = 58 * MiB, WS_XB = 170 * MiB, WS_XB0 = 204 * MiB, WS_END = 238 * MiB;
static_assert((size_t)2 * PO * D * 2 <= WS_WOUT && WS_H + (size_t)M * D * 2 <= WS_PROJ && WS_PROJ + (size_t)M * PO * 2 <= WS_XB && WS_XB + (size_t)M * D * 2 <= WS_XB0 && WS_XB0 + (size_t)M * D * 2 <= WS_END, "ws map");
constexpr size_t WS_SILU = 22 * MiB + 512 * 1024;
constexpr size_t WS_BAR = 23 * MiB, BAR_BYTES = 16384;
constexpr int QUEUE_WORD = 3584;
constexpr int LDS_BYTES = 131072 + 1024;

struct Args { const float* in[16]; float* out; unsigned char* ws; };

__device__ __forceinline__ unsigned pk_bf16(float lo, float hi) { typedef float f2 __attribute__((ext_vector_type(2))); typedef __bf16 b2 __attribute__((ext_vector_type(2)));
    f2 v = {lo, hi}; b2 b = __builtin_convertvector(v, b2); return __builtin_bit_cast(unsigned, b); }
__device__ __forceinline__ void unpack8(const u32x4 w, float (&f)[8]) {
    f[0] = __uint_as_float(w.x << 16); f[1] = __uint_as_float(w.x & 0xffff0000u); f[2] = __uint_as_float(w.y << 16); f[3] = __uint_as_float(w.y & 0xffff0000u);
    f[4] = __uint_as_float(w.z << 16); f[5] = __uint_as_float(w.z & 0xffff0000u); f[6] = __uint_as_float(w.w << 16); f[7] = __uint_as_float(w.w & 0xffff0000u); }
__device__ __forceinline__ u32x4 pack8(const float (&f)[8]) { u32x4 w; w.x = pk_bf16(f[0], f[1]); w.y = pk_bf16(f[2], f[3]); w.z = pk_bf16(f[4], f[5]); w.w = pk_bf16(f[6], f[7]); return w; }
constexpr float LOG2E_ = 1.4426950408889634f;
__device__ __forceinline__ float silu_f(float v) { return v * __builtin_amdgcn_rcpf(1.0f + __builtin_amdgcn_exp2f(-v * LOG2E_)); }
__device__ __forceinline__ int crow(int r, int hi) { return (r & 3) + 8 * (r >> 2) + 4 * hi; }
__device__ __forceinline__ float wave_sum(float v) {
#pragma unroll
    for (int o = 1; o < 64; o <<= 1) v += __shfl_xor(v, o);
    return v;
}

namespace pg8 {
struct EpiGate {
    static constexpr bool PERM = true, AFTER_DRAIN = false;
    const float* xf; const bf16_t* xb;
    float* outf; bf16_t* outb;
    const float* gate;
    bool first;
    __device__ __forceinline__ void operator()(const f32x4 (&acc)[2][2][4][2], const Unit& u, int wr, int wc, int fr, int fq) const {
        const int col0 = u.pn * BM + wc * 32 + 8 * fq;
        const float* gp = gate + (size_t)(u.pm >> 4) * 3072 + col0;
        const bool l0 = first;
        f32x4 gv[2][2];
#pragma unroll
        for (int bj = 0; bj < 2; ++bj)
#pragma unroll
            for (int nn = 0; nn < 2; ++nn) gv[bj][nn] = *(const f32x4*)(gp + bj * HALF + nn * 4);
#pragma unroll
        for (int ai = 0; ai < 2; ++ai) {
            u32x4 xw[4][2];
#pragma unroll
            for (int mi = 0; mi < 4; ++mi) { const bf16_t* bp = xb + (size_t)(u.pm * BM + ai * HALF + wr * 64 + mi * 16 + fr) * 1024 + col0;
#pragma unroll
                for (int bj = 0; bj < 2; ++bj) xw[mi][bj] = __builtin_nontemporal_load((const u32x4*)(bp + bj * HALF)); }
#pragma unroll
            for (int mi = 0; mi < 4; ++mi) { const size_t ro = (size_t)(u.pm * BM + ai * HALF + wr * 64 + mi * 16 + fr) * 1024 + col0;
#pragma unroll
                for (int bj = 0; bj < 2; ++bj) { const u32x4 w = xw[mi][bj];
                    const f32x4 x0 = (f32x4){__uint_as_float(w.x << 16), __uint_as_float(w.x & 0xffff0000u), __uint_as_float(w.y << 16), __uint_as_float(w.y & 0xffff0000u)};
                    const f32x4 x1 = (f32x4){__uint_as_float(w.z << 16), __uint_as_float(w.z & 0xffff0000u), __uint_as_float(w.w << 16), __uint_as_float(w.w & 0xffff0000u)};
                    const f32x4 v0 = x0 + gv[bj][0] * acc[ai][bj][mi][0], v1 = x1 + gv[bj][1] * acc[ai][bj][mi][1];
                    if (l0) { u32x4 o; o.x = cvt_pk_bf16(v0[0], v0[1]); o.y = cvt_pk_bf16(v0[2], v0[3]); o.z = cvt_pk_bf16(v1[0], v1[1]); o.w = cvt_pk_bf16(v1[2], v1[3]);
                              *(u32x4*)(outb + ro + bj * HALF) = o; }
                    else { __builtin_nontemporal_store(v0, (f32x4*)(outf + ro + bj * HALF)); __builtin_nontemporal_store(v1, (f32x4*)(outf + ro + bj * HALF + 4)); }
                } }
        }
    }
};
}


namespace pg8 {
struct EpiProj {
    static constexpr bool PERM = true, AFTER_DRAIN = false;
    bf16_t* O;
    __device__ __forceinline__ void operator()(const f32x4 (&acc)[2][2][4][2], const Unit& u, int wr, int wc, int fr, int fq) const {
        const int row0 = u.pm * BM + wr * 64 + fr;
        if (u.pn < 8) {
            const bool bz = u.pn >= 4;
            const int col0 = (bz ? 512 + (u.pn - 4) * 128 : u.pn * 128) + wc * 32 + 8 * fq;
#pragma unroll
            for (int ai = 0; ai < 2; ++ai)
#pragma unroll
                for (int m = 0; m < 4; ++m) {
                    const f32x4 a0 = acc[ai][0][m][0], a1 = acc[ai][0][m][1], b0 = acc[ai][1][m][0], b1 = acc[ai][1][m][1];
                    f32x4 v0, v1;
                    if (bz) { v0 = (f32x4){a0[0] * silu_f(b0[0]), a0[1] * silu_f(b0[1]), a0[2] * silu_f(b0[2]), a0[3] * silu_f(b0[3])};
                              v1 = (f32x4){a1[0] * silu_f(b1[0]), a1[1] * silu_f(b1[1]), a1[2] * silu_f(b1[2]), a1[3] * silu_f(b1[3])}; }
                    else { v0 = a0 * b0; v1 = a1 * b1; }
                    u32x4 w; w.x = cvt_pk_bf16(v0[0], v0[1]); w.y = cvt_pk_bf16(v0[2], v0[3]); w.z = cvt_pk_bf16(v1[0], v1[1]); w.w = cvt_pk_bf16(v1[2], v1[3]);
                    *(u32x4*)(O + (size_t)(row0 + ai * HALF + m * 16) * PO2 + col0) = w;
                }
        } else {
            const int col0 = u.pn * BM - 1024 + wc * 32 + 8 * fq;
            const bool za = u.pn >= 11;
#pragma unroll
            for (int ai = 0; ai < 2; ++ai)
#pragma unroll
                for (int m = 0; m < 4; ++m) { bf16_t* rowp = O + (size_t)(row0 + ai * HALF + m * 16) * PO2 + col0;
#pragma unroll
                    for (int bj = 0; bj < 2; ++bj) { f32x4 v0 = acc[ai][bj][m][0], v1 = acc[ai][bj][m][1];
                        if (za) { v0 = (f32x4){silu_f(v0[0]), silu_f(v0[1]), silu_f(v0[2]), silu_f(v0[3])}; v1 = (f32x4){silu_f(v1[0]), silu_f(v1[1]), silu_f(v1[2]), silu_f(v1[3])}; }
                        u32x4 w; w.x = cvt_pk_bf16(v0[0], v0[1]); w.y = cvt_pk_bf16(v0[2], v0[3]); w.z = cvt_pk_bf16(v1[0], v1[1]); w.w = cvt_pk_bf16(v1[2], v1[3]);
                        *(u32x4*)(rowp + bj * HALF) = w; } }
        }
    }
};
}

__device__ __forceinline__ unsigned f2bf_rne(float f) { unsigned u = __float_as_uint(f); return (u + 0x7fffu + ((u >> 16) & 1u)) >> 16; }
__device__ __forceinline__ unsigned pk2(float lo, float hi) { return f2bf_rne(lo) | (f2bf_rne(hi) << 16); }
__device__ __forceinline__ int win_row_of_col(int c) {
    if (c >= 2048) return c;
    const int grp = c >> 9, cc = c & 511, t = cc >> 7, j = cc & 127;
    return (grp == 1) ? 256 * t + j : (grp == 2) ? 256 * t + 128 + j : (grp == 0) ? 256 * (4 + t) + j : 256 * (4 + t) + 128 + j;
}
template <bool REMAP>
__device__ __forceinline__ void p0_transpose_item(const float* W, int K, int N, bf16_t* WT, LAS float* scr, int item, int lane) {
    const int nblk = N / 32, kb = item / nblk, nb = item % nblk, k0 = 64 * kb, n0 = 32 * nb;
    const int r0 = REMAP ? win_row_of_col(n0) : n0;
#pragma unroll
    for (int i = 0; i < 32; ++i) { const int kk = 2 * i + (lane >> 5); scr[kk * 33 + (lane & 31)] = __builtin_nontemporal_load(W + (size_t)(k0 + kk) * N + n0 + (lane & 31)); }
    asm volatile("s_waitcnt lgkmcnt(0)" ::: "memory");
    const int c = lane & 7;
#pragma unroll
    for (int j = 0; j < 4; ++j) { const int n = (lane >> 3) + 8 * j; const LAS float* s = scr + (8 * c) * 33 + n;
        u32x4 o; o.x = pk2(s[0 * 33], s[1 * 33]); o.y = pk2(s[2 * 33], s[3 * 33]); o.z = pk2(s[4 * 33], s[5 * 33]); o.w = pk2(s[6 * 33], s[7 * 33]);
        *(u32x4*)(WT + (size_t)(r0 + n) * K + k0 + 8 * c) = o; }
    asm volatile("s_waitcnt lgkmcnt(0)" ::: "memory");
}

__device__ __forceinline__ void p0_silu_table(const Args& a, int tid, int bid, int G) {
    u32x4* tabs = (u32x4*)(a.ws + WS_SILU);
    for (int e = bid * 512 + tid; e < 5 * 64 * 64; e += G * 512) {
        const int ln = e & 63, ks = (e >> 6) & 63, rt = e >> 12;
        const int row = 32 * rt + (ln & 31), k0 = 16 * ks + 8 * (ln >> 5);
        u32x4 pw = {0u, 0u, 0u, 0u};
        if (row < NMOD) {
            const float* cp = row < NPB ? a.in[2] + (size_t)row * D : a.in[3] + (size_t)(row - NPB) * D;
            const f32x4 c0 = *(const f32x4*)(cp + k0), c1 = *(const f32x4*)(cp + k0 + 4);
            float cv[8] = {silu_f(c0.x), silu_f(c0.y), silu_f(c0.z), silu_f(c0.w), silu_f(c1.x), silu_f(c1.y), silu_f(c1.z), silu_f(c1.w)};
            pw = pack8(cv);
        }
        tabs[e] = pw;
    }
}
__device__ __forceinline__ void p0_mod_item(const Args& a, LAS unsigned char* lds, int it, int tid, int lane, int wave) {
    const int l = it / 96, col0 = (it % 96) * 32;
    const float* W = a.in[7] + (size_t)l * D * 3072;
    const int n = lane & 31, kq = lane >> 5;
    f32x16 acc[5];
#pragma unroll
    for (int rt = 0; rt < 5; ++rt)
#pragma unroll
        for (int i = 0; i < 16; ++i) acc[rt][i] = 0.f;
    const u32x4* tabs = (const u32x4*)(a.ws + WS_SILU) + (size_t)(wave * 8) * 64 + lane;
    const float* wp = W + (size_t)(wave * 128 + 8 * kq) * 3072 + col0 + n;
#pragma unroll 1
    for (int kp = 0; kp < 4; ++kp) {
        float wv[2][8]; u32x4 af[2][5];
#pragma unroll
        for (int h = 0; h < 2; ++h) {
#pragma unroll
            for (int j = 0; j < 8; ++j) wv[h][j] = __builtin_nontemporal_load(wp + (size_t)(h * 16 + j) * 3072);
#pragma unroll
            for (int rt = 0; rt < 5; ++rt) af[h][rt] = tabs[(rt * 64 + h) * 64];
        }
#pragma unroll
        for (int h = 0; h < 2; ++h) {
            const bf16x8 bfrag = __builtin_bit_cast(bf16x8, pack8(wv[h]));
#pragma unroll
            for (int rt = 0; rt < 5; ++rt) acc[rt] = __builtin_amdgcn_mfma_f32_32x32x16_bf16(__builtin_bit_cast(bf16x8, af[h][rt]), bfrag, acc[rt], 0, 0, 0);
        }
        wp += (size_t)32 * 3072; tabs += 2 * 64;
    }
    LAS float* red = (LAS float*)lds;
    LAS float* rb = red + (4 * kq) * 32 + n;
#pragma unroll 1
    for (int w = 0; w < 8; ++w) {
        if (wave == w) {
#pragma unroll
            for (int rt = 0; rt < 5; ++rt)
#pragma unroll
                for (int i = 0; i < 16; ++i) { const int off = (32 * rt + (i & 3) + 8 * (i >> 2)) * 32; const float prev = (w == 0) ? 0.f : rb[off]; rb[off] = prev + acc[rt][i]; }
        }
        __syncthreads();
    }
    float* mod = (float*)(a.ws + WS_MOD);
    const float* bm = a.in[8] + (size_t)l * 3072;
    for (int e = tid; e < NMOD * 32; e += 512) { const int row = e >> 5, c = e & 31; mod[((size_t)l * NMOD + row) * 3072 + col0 + c] = red[e] + bm[col0 + c]; }
    __syncthreads();
}

__device__ __forceinline__ void transposes_layer(const Args& a, int l, LAS unsigned char* lds, int lane, int wave, int vrot, int nvb) {
    LAS float* scr = (LAS float*)(lds + wave * 16384);
    constexpr int I_IN = (D / 64) * (PO / 32), I_OUT = (D / 64) * (D / 32);
    bf16_t* WinT = (bf16_t*)(a.ws + WS_WIN) + (size_t)l * PO * D; bf16_t* WoutT = (bf16_t*)(a.ws + WS_WOUT) + (size_t)l * D * D;
    for (int it = vrot * 8 + wave; it < I_IN + I_OUT; it += nvb * 8) {
        if (it < I_IN) p0_transpose_item<true>(a.in[10] + (size_t)l * D * PO, D, PO, WinT, scr, it, lane);
        else p0_transpose_item<false>(a.in[15] + (size_t)l * D * D, D, D, WoutT, scr, it - I_IN, lane);
    }
    __syncthreads();
}
__device__ __forceinline__ void p0_rope(const Args& a, int tid, int bid, int G) {
    float* tab = (float*)(a.ws + WS_ROPE);
    for (int e = bid * 512 + tid; e < (LP + LS) * 8; e += G * 512) {
        const int p = e >> 3, j = e & 7;
        const float pos = (float)(p < LP ? p : 8192 + (p - LP));
        const float inv = (float)exp(-(double)j * 1.640295422175541);
        const float angf = pos * inv;
        const double ang = (double)angf;
        const double twopi = 6.283185307179586476925;
        const double kk = __builtin_rint(ang / twopi);
        const float red = (float)(ang - kk * twopi);
        tab[p * 16 + j] = cosf(red); tab[p * 16 + 8 + j] = sinf(red);
    }
}

constexpr int FLAG_WORD = QUEUE_WORD + 128;
__device__ __forceinline__ void p0_phase(const Args& a, LAS unsigned char* lds, int tid, int lane, int wave, int bid, int G) {
    unsigned* flag = (unsigned*)(a.ws + WS_BAR) + FLAG_WORD;
    constexpr int NENT = 5 * 64 * 64;
    const int nprod = (NENT + 511) / 512 < G ? (NENT + 511) / 512 : G;
    p0_silu_table(a, tid, bid, G);
    if (bid < nprod) {
        asm volatile("s_waitcnt vmcnt(0)" ::: "memory");
        __syncthreads();
        if (tid == 0) { __builtin_amdgcn_fence(__ATOMIC_RELEASE, "agent"); asm volatile("s_waitcnt vmcnt(0)" ::: "memory");
                        __hip_atomic_fetch_add(flag, 1u, __ATOMIC_RELAXED, __HIP_MEMORY_SCOPE_AGENT); }
    }
    p0_rope(a, tid, bid, G);
    {
        const int nmod = G < 192 ? G : 192;
        const int vrot = (bid >= nmod) ? bid - nmod : bid + (G - nmod);
        transposes_layer(a, 0, lds, lane, wave, vrot, G);
    }
    if (bid < 192 || G < 192) {
        if (tid == 0) {
            unsigned sp = 0;
            while (__hip_atomic_load(flag, __ATOMIC_RELAXED, __HIP_MEMORY_SCOPE_AGENT) < (unsigned)nprod) { __builtin_amdgcn_s_sleep(2); if (++sp > (1u << 22)) break; }
            __builtin_amdgcn_fence(__ATOMIC_ACQUIRE, "agent"); asm volatile("s_waitcnt vmcnt(0)" ::: "memory");
        }
        __syncthreads();
        asm volatile("" : "+v"(tid)); lane = tid & 63;
        for (int it = bid; it < 192; it += G) p0_mod_item(a, lds, it, tid, lane, wave);
    }
    {
        unsigned* head = (unsigned*)(a.ws + WS_BAR) + QUEUE_WORD + 192;
        volatile LAS unsigned* slot = (volatile LAS unsigned*)(lds + 131072 + 128);
        bf16_t* XB0 = (bf16_t*)(a.ws + WS_XB0);
        for (;;) {
            if (threadIdx.x == 0) slot[0] = __hip_atomic_fetch_add(head, 1u, __ATOMIC_RELAXED, __HIP_MEMORY_SCOPE_AGENT);
            __syncthreads();
            const int q = (int)slot[0];
            __syncthreads();
            if (q >= M / 64) break;
            asm volatile("" : "+v"(tid)); lane = tid & 63;
            f32x4 v[8][4];
#pragma unroll
            for (int r = 0; r < 8; ++r) { const int row = q * 64 + wave * 8 + r;
                const float* xrow = row < MP ? a.in[0] + (size_t)row * D : a.in[1] + (size_t)(row - MP) * D;
#pragma unroll
                for (int j = 0; j < 4; ++j) v[r][j] = __builtin_nontemporal_load((const f32x4*)xrow + 64 * j + lane); }
#pragma unroll
            for (int r = 0; r < 8; ++r) { const int row = q * 64 + wave * 8 + r;
#pragma unroll
                for (int j = 0; j < 4; ++j) { u32x2 o; o.x = pk_bf16(v[r][j].x, v[r][j].y); o.y = pk_bf16(v[r][j].z, v[r][j].w); *((u32x2*)(XB0 + (size_t)row * D) + 64 * j + lane) = o; } }
        }
    }
}
__device__ __forceinline__ void p_norm(const Args& a, int l, int lane, int wave, int bid, int G) {
    const int gw = bid * 8 + wave, NGW = G * 8;
    const float* mod = (const float*)(a.ws + WS_MOD) + (size_t)l * NMOD * 3072;
    const float* g = a.in[9] + (size_t)l * D;
    bf16_t* H = (bf16_t*)(a.ws + WS_H);
    const bf16_t* X = (const bf16_t*)(a.ws + (l == 0 ? WS_XB0 : WS_XB));
#define NORM_LOAD(V, ROW) do { const u32x2* xr_ = (const u32x2*)(X + (size_t)(ROW) * D); _Pragma("unroll") for (int j = 0; j < 4; ++j) { const u32x2 w_ = xr_[64 * j + lane]; \
        V[j] = (f32x4){__uint_as_float(w_.x << 16), __uint_as_float(w_.x & 0xffff0000u), __uint_as_float(w_.y << 16), __uint_as_float(w_.y & 0xffff0000u)}; } } while (0)
#define NORM_FINISH(V, ROW, GS, SH) do { float ss_ = 0.f; _Pragma("unroll") for (int j = 0; j < 4; ++j) ss_ += (V[j].x * V[j].x + V[j].y * V[j].y) + (V[j].z * V[j].z + V[j].w * V[j].w); \
        const float rstd_ = rsqrtf(wave_sum(ss_) * (1.0f / D) + EPS); \
        _Pragma("unroll") for (int j = 0; j < 4; ++j) { const f32x4 h_ = V[j] * rstd_ * GS[j] + SH[j]; u32x2 o_; o_.x = pk_bf16(h_.x, h_.y); o_.y = pk_bf16(h_.z, h_.w); \
            *((u32x2*)(H + (size_t)(ROW) * D) + 64 * j + lane) = o_; } } while (0)
    {
        const int wps = NGW / NPB, n = gw / wps, lw = gw - n * wps;
        const float* mp = mod + (size_t)n * 3072;
        f32x4 gs[4], sh[4];
#pragma unroll
        for (int j = 0; j < 4; ++j) { gs[j] = *((const f32x4*)g + 64 * j + lane) * (*((const f32x4*)(mp + D) + 64 * j + lane) + 1.0f); sh[j] = *((const f32x4*)mp + 64 * j + lane); }
#pragma unroll 1
        for (int r0 = lw; r0 < LP; r0 += 4 * wps) {
            f32x4 v0[4], v1[4], v2[4], v3[4];
            const int ra = n * LP + r0, rb = ra + wps, rc = rb + wps, rd = rc + wps;
            const bool hb = r0 + wps < LP, hc = r0 + 2 * wps < LP, hd = r0 + 3 * wps < LP;
            NORM_LOAD(v0, ra); if (hb) NORM_LOAD(v1, rb); if (hc) NORM_LOAD(v2, rc); if (hd) NORM_LOAD(v3, rd);
            NORM_FINISH(v0, ra, gs, sh); if (hb) NORM_FINISH(v1, rb, gs, sh); if (hc) NORM_FINISH(v2, rc, gs, sh); if (hd) NORM_FINISH(v3, rd, gs, sh);
        }
    }
#pragma unroll 1
    for (int row = MP + gw; row < M; row += NGW) {
        const float* mp = mod + (size_t)(NPB + ((row - MP) >> 3)) * 3072;
        f32x4 gs[4], sh[4], v0[4];
        NORM_LOAD(v0, row);
#pragma unroll
        for (int j = 0; j < 4; ++j) { gs[j] = *((const f32x4*)g + 64 * j + lane) * (*((const f32x4*)(mp + D) + 64 * j + lane) + 1.0f); sh[j] = *((const f32x4*)mp + 64 * j + lane); }
        NORM_FINISH(v0, row, gs, sh);
    }
#undef NORM_LOAD
#undef NORM_FINISH
}

__device__ __forceinline__ void normrope8(float (&v)[8], int sub, const float* gain, const float* tabrow) {
    float ss = 0.f;
#pragma unroll
    for (int i = 0; i < 8; ++i) ss += v[i] * v[i];
    ss += __shfl_xor(ss, 1); ss += __shfl_xor(ss, 2); ss += __shfl_xor(ss, 4);
    const float rstd = rsqrtf(ss * (1.0f / 64.0f) + EPS);
    const f32x4 g0 = *(const f32x4*)(gain + sub * 8), g1 = *(const f32x4*)(gain + sub * 8 + 4);
    v[0] *= rstd * g0.x; v[1] *= rstd * g0.y; v[2] *= rstd * g0.z; v[3] *= rstd * g0.w; v[4] *= rstd * g1.x; v[5] *= rstd * g1.y; v[6] *= rstd * g1.z; v[7] *= rstd * g1.w;
    float pr[8];
#pragma unroll
    for (int i = 0; i < 8; ++i) pr[i] = __shfl_xor(v[i], 1);
    if (sub < 2) {
        const f32x4 c0 = *(const f32x4*)(tabrow), c1 = *(const f32x4*)(tabrow + 4), s0 = *(const f32x4*)(tabrow + 8), s1 = *(const f32x4*)(tabrow + 12);
        const float cs[8] = {c0.x, c0.y, c0.z, c0.w, c1.x, c1.y, c1.z, c1.w}, sn[8] = {s0.x, s0.y, s0.z, s0.w, s1.x, s1.y, s1.z, s1.w};
        const float sg = (sub == 0) ? -1.0f : 1.0f;
#pragma unroll
        for (int i = 0; i < 8; ++i) v[i] = v[i] * cs[i] + sg * pr[i] * sn[i];
    }
}

__device__ __forceinline__ s16x4 vtr(const LAS unsigned char* p) { return __builtin_bit_cast(s16x4, __builtin_amdgcn_ds_read_tr16_b64_v4i16((LAS v4i16_t*)p)); }

template <bool SAMPLE>
__device__ __forceinline__ void attn_prefetch(const bf16_t* __restrict__ proj, int row0, int head0, int lane, u32x4 (&qw)[4], u32x4 (&zw)[4]) {
    const int r32 = lane & 31, hi = lane >> 5;
    const int myrow = SAMPLE ? row0 + (r32 & 7) : row0 + r32;
    const int myhead = SAMPLE ? head0 + (r32 >> 3) : head0;
    const bf16_t* qp = proj + (size_t)myrow * PO2 + C_Q + myhead * 64 + hi * 8;
#pragma unroll
    for (int d0 = 0; d0 < 4; ++d0) qw[d0] = *(const u32x4*)(qp + d0 * 16);
#pragma unroll
    for (int it4 = 0; it4 < 4; ++it4) {
        const int qq = it4 * 8 + (lane >> 3), ch = lane & 7;
        const int orow = SAMPLE ? row0 + (qq & 7) : row0 + qq;
        const int ohead = SAMPLE ? head0 + (qq >> 3) : head0;
        zw[it4] = *(const u32x4*)(proj + (size_t)orow * PO2 + C_ZA + ohead * 64 + ch * 8);
    }
}
template <bool SAMPLE>
__device__ __forceinline__ void attn_tile32(const u32x4 (&qw)[4], const u32x4 (&zw)[4], bf16_t* __restrict__ Y, const float* __restrict__ tab, const float* __restrict__ qg, const float* __restrict__ sinks,
                                            const LAS unsigned char* Kl, const LAS unsigned char* Vl, int vhalf, LAS float* wsf, LAS bf16_t* ost,
                                            int row0, int head0, int pos0, int tmin, int lane) {
    const int r32 = lane & 31, hi = lane >> 5;
    const int myhead = SAMPLE ? head0 + (r32 >> 3) : head0;
    const int mypos = SAMPLE ? pos0 + (r32 & 7) : pos0 + r32;
    float q[4][8];
#pragma unroll
    for (int d0 = 0; d0 < 4; ++d0) unpack8(qw[d0], q[d0]);
    float ss = 0.f;
#pragma unroll
    for (int d0 = 0; d0 < 4; ++d0)
#pragma unroll
        for (int i = 0; i < 8; ++i) ss += q[d0][i] * q[d0][i];
    ss += __shfl_xor(ss, 32);
    const float rstd = rsqrtf(ss * (1.0f / 64.0f) + EPS);
#pragma unroll
    for (int d0 = 0; d0 < 4; ++d0) { const f32x4 g0 = *(const f32x4*)(qg + d0 * 16 + hi * 8), g1 = *(const f32x4*)(qg + d0 * 16 + hi * 8 + 4);
        q[d0][0] *= rstd * g0.x; q[d0][1] *= rstd * g0.y; q[d0][2] *= rstd * g0.z; q[d0][3] *= rstd * g0.w; q[d0][4] *= rstd * g1.x; q[d0][5] *= rstd * g1.y; q[d0][6] *= rstd * g1.z; q[d0][7] *= rstd * g1.w; }
    {
        const float* tr = tab + (size_t)mypos * 16;
        const f32x4 c0 = *(const f32x4*)(tr), c1 = *(const f32x4*)(tr + 4), s0 = *(const f32x4*)(tr + 8), s1 = *(const f32x4*)(tr + 12);
        const float cs[8] = {c0.x, c0.y, c0.z, c0.w, c1.x, c1.y, c1.z, c1.w}, sn[8] = {s0.x, s0.y, s0.z, s0.w, s1.x, s1.y, s1.z, s1.w};
        const float sg = (hi == 0) ? -1.0f : 1.0f;
#pragma unroll
        for (int i = 0; i < 8; ++i) { const float pr = __shfl_xor(q[0][i], 32); q[0][i] = q[0][i] * cs[i] + sg * pr * sn[i]; }
    }
    bf16x8 qr[4];
#pragma unroll
    for (int d0 = 0; d0 < 4; ++d0) {
#pragma unroll
        for (int i = 0; i < 8; ++i) q[d0][i] *= 0.125f * LOG2E;
        qr[d0] = __builtin_bit_cast(bf16x8, pack8(q[d0])); }
    f32x16 p[5];
    const int rq = SAMPLE ? (r32 & 7) : r32;
    const int lo = rq + 1 - 4 * hi, hi_ = rq - 4 * hi;
    float mx = -1e30f;
#pragma unroll
    for (int t = 0; t < 5; ++t) {
        if (t >= tmin) {
#pragma unroll
            for (int i = 0; i < 16; ++i) p[t][i] = 0.f;
#pragma unroll
            for (int d0 = 0; d0 < 4; ++d0) { const bf16x8 kf = *(const LAS bf16x8*)(Kl + (32 * t + r32) * 144 + (16 * d0 + 8 * hi) * 2);
                p[t] = __builtin_amdgcn_mfma_f32_32x32x16_bf16(kf, qr[d0], p[t], 0, 0, 0); }
            if (t == 0) {
#pragma unroll
                for (int i = 0; i < 16; ++i) { const int kc = (i & 3) + 8 * (i >> 2); p[t][i] = (kc >= lo) ? p[t][i] : -1e30f; }
            }
            if (t == 4) {
#pragma unroll
                for (int i = 0; i < 16; ++i) { const int kc = (i & 3) + 8 * (i >> 2); p[t][i] = (kc <= hi_) ? p[t][i] : -1e30f; }
            }
        } else {
#pragma unroll
            for (int i = 0; i < 16; ++i) p[t][i] = -1e30f;
        }
#pragma unroll
        for (int i = 0; i < 16; ++i) mx = fmaxf(mx, p[t][i]);
    }
    mx = fmaxf(mx, __shfl_xor(mx, 32));
    const float sk = sinks[myhead] * LOG2E;
    mx = fmaxf(mx, sk);
    float lsum = 0.f;
    u32x4 pw[5][2];
#pragma unroll
    for (int t = 0; t < 5; ++t) {
#pragma unroll
        for (int i = 0; i < 16; ++i) { p[t][i] = __builtin_amdgcn_exp2f(p[t][i] - mx); lsum += p[t][i]; }
#pragma unroll
        for (int s = 0; s < 2; ++s) { pw[t][s].x = pk_bf16(p[t][8 * s + 0], p[t][8 * s + 1]); pw[t][s].y = pk_bf16(p[t][8 * s + 2], p[t][8 * s + 3]); pw[t][s].z = pk_bf16(p[t][8 * s + 4], p[t][8 * s + 5]); pw[t][s].w = pk_bf16(p[t][8 * s + 6], p[t][8 * s + 7]); }
    }
    lsum += __shfl_xor(lsum, 32);
    const float denom = lsum + __builtin_amdgcn_exp2f(sk - mx);
    if (hi == 0) wsf[r32] = 1.0f / denom;
    __builtin_amdgcn_sched_barrier(0);
    f32x16 o[2];
#pragma unroll
    for (int d0 = 0; d0 < 2; ++d0)
#pragma unroll
        for (int i = 0; i < 16; ++i) o[d0][i] = 0.f;
    const int i16 = lane & 15;
    const LAS unsigned char* vb = Vl + (4 * hi + (i16 >> 2)) * 64 + ((lane >> 4) & 1) * 32 + (i16 & 3) * 8;
#pragma unroll
    for (int t = 0; t < 5; ++t)
#pragma unroll
        for (int s = 0; s < 2; ++s) {
            const bf16x8 pa = __builtin_bit_cast(bf16x8, pw[t][s]);
#pragma unroll
            for (int d0 = 0; d0 < 2; ++d0) {
                const s16x4 vlo = vtr(vb + d0 * vhalf + (32 * t + 16 * s) * 64), vhi = vtr(vb + d0 * vhalf + (32 * t + 16 * s + 8) * 64);
                const bf16x8 vf = (bf16x8){vlo[0], vlo[1], vlo[2], vlo[3], vhi[0], vhi[1], vhi[2], vhi[3]};
                o[d0] = __builtin_amdgcn_mfma_f32_32x32x16_bf16(pa, vf, o[d0], 0, 0, 0);
            }
        }
    __builtin_amdgcn_sched_barrier(0);
    asm volatile("s_waitcnt lgkmcnt(0)" ::: "memory");
#pragma unroll
    for (int i = 0; i < 16; ++i) {
        const int qq = crow(i, hi);
        const float rl = wsf[qq];
#pragma unroll
        for (int d0 = 0; d0 < 2; ++d0) ost[qq * 64 + d0 * 32 + r32] = (bf16_t)(pk_bf16(o[d0][i] * rl, 0.f) & 0xffffu);
    }
    asm volatile("s_waitcnt lgkmcnt(0)" ::: "memory");
#pragma unroll
    for (int it4 = 0; it4 < 4; ++it4) {
        const int qq = it4 * 8 + (lane >> 3), ch = lane & 7;
        const int orow = SAMPLE ? row0 + (qq & 7) : row0 + qq;
        const int ohead = SAMPLE ? head0 + (qq >> 3) : head0;
        const u32x4 ow = *(const LAS u32x4*)(ost + qq * 64 + ch * 8);
        float of[8], zf[8], yv[8];
        unpack8(ow, of); unpack8(zw[it4], zf);
#pragma unroll
        for (int k = 0; k < 8; ++k) yv[k] = of[k] * zf[k];
        *(u32x4*)(Y + (size_t)orow * D + 512 + ohead * 64 + ch * 8) = pack8(yv);
    }
    asm volatile("s_waitcnt lgkmcnt(0)" ::: "memory");
}

__device__ __forceinline__ void attn_prompt_item(const Args& a, int l, int item, LAS unsigned char* lds, int tid, int lane, int wave) {
    const int kvh = item & 1, b = (item >> 1) & 31, n = item >> 6;
    const bf16_t* proj = (const bf16_t*)(a.ws + WS_PROJ); bf16_t* Y = (bf16_t*)(a.ws + WS_H);
    const float* tab = (const float*)(a.ws + WS_ROPE);
    const float* kg = a.in[13] + l * 64; const float* qg = a.in[12] + l * 64; const float* sinks = a.in[14] + l * 8;
    LAS unsigned char* Kl = lds; LAS unsigned char* Vl = lds + 36864; LAS float* wsf = (LAS float*)(lds + 36864 + 32768) + wave * 64; LAS bf16_t* ost = (LAS bf16_t*)(lds + 73728 + wave * 4096);
    const int headw = kvh * 4 + (wave >> 1), qt0 = (wave & 1) * 2, rowq0 = n * LP + b * 128 + qt0 * 32;
    u32x4 qw0[4], zw0[4], qw1[4], zw1[4];
    attn_prefetch<false>(proj, rowq0, headw, lane, qw0, zw0); attn_prefetch<false>(proj, rowq0 + 32, headw, lane, qw1, zw1);
    const int sub = tid & 7, rl = tid >> 3;
    u32x4 kws[4], vws[4];
#pragma unroll
    for (int pass = 0; pass < 4; ++pass) {
        const int j = pass * 64 + rl; const int pos = 128 * (b - 1) + j; const int posc = pos < 0 ? 0 : pos;
        const size_t row = (size_t)n * LP + posc;
        kws[pass] = *(const u32x4*)(proj + row * PO2 + C_K + kvh * 64 + sub * 8);
        vws[pass] = *(const u32x4*)(proj + row * PO2 + C_V + kvh * 64 + sub * 8);
    }
#pragma unroll
    for (int pass = 0; pass < 4; ++pass) {
        const int j = pass * 64 + rl; const int pos = 128 * (b - 1) + j; const int posc = pos < 0 ? 0 : pos;
        const u32x4 kw = kws[pass], vw = vws[pass];
        float kf[8]; unpack8(kw, kf);
        normrope8(kf, sub, kg, tab + (size_t)posc * 16);
        *(LAS u32x4*)(Kl + j * 144 + sub * 16) = pack8(kf);
        *(LAS u32x4*)(Vl + (sub >> 2) * 16384 + j * 64 + (sub & 3) * 16) = vw;
        if (b == 31 && j >= 128) {
            float* okp = a.out + O_KP + (((size_t)(l * NPB + n) * 128 + (j - 128)) * 2 + kvh) * 64 + sub * 8;
            float* ovp = a.out + O_VP + (((size_t)(l * NPB + n) * 128 + (j - 128)) * 2 + kvh) * 64 + sub * 8;
            float vf[8]; unpack8(vw, vf);
            *(f32x4*)okp = (f32x4){kf[0], kf[1], kf[2], kf[3]}; *(f32x4*)(okp + 4) = (f32x4){kf[4], kf[5], kf[6], kf[7]};
            *(f32x4*)ovp = (f32x4){vf[0], vf[1], vf[2], vf[3]}; *(f32x4*)(ovp + 4) = (f32x4){vf[4], vf[5], vf[6], vf[7]};
        }
    }
    __syncthreads();
    attn_tile32<false>(qw0, zw0, Y, tab, qg, sinks, Kl + 32 * qt0 * 144, Vl + 32 * qt0 * 64, 16384, wsf, ost, rowq0, headw, b * 128 + qt0 * 32, (b == 0) ? 4 - qt0 : 0, lane);
    attn_tile32<false>(qw1, zw1, Y, tab, qg, sinks, Kl + 32 * (qt0 + 1) * 144, Vl + 32 * (qt0 + 1) * 64, 16384, wsf, ost, rowq0 + 32, headw, b * 128 + qt0 * 32 + 32, (b == 0) ? 3 - qt0 : 0, lane);
    __syncthreads();
}

__device__ __forceinline__ void attn_sample_item(const Args& a, int l, int n, LAS unsigned char* lds, int tid, int lane, int wave) {
    const bf16_t* proj = (const bf16_t*)(a.ws + WS_PROJ); bf16_t* Y = (bf16_t*)(a.ws + WS_H);
    const float* tab = (const float*)(a.ws + WS_ROPE);
    const float* kg = a.in[13] + l * 64; const float* qg = a.in[12] + l * 64; const float* sinks = a.in[14] + l * 8;
    constexpr int KH = 160 * 144  , VOFF = 2 * KH  , VH = 160 * 64  ;
    LAS float* wsf = (LAS float*)(lds + 98304) + wave * 64; LAS bf16_t* ost = (LAS bf16_t*)(lds + 102400 + wave * 4096);
    const float* ck = a.in[5] + (size_t)(l * NSB + n) * 128 * 128; const float* cv = a.in[6] + (size_t)(l * NSB + n) * 128 * 128;
    float* oks = a.out + O_KS + (size_t)(l * NSB + n) * 128 * 128; float* ovs = a.out + O_VS + (size_t)(l * NSB + n) * 128 * 128;
    const int c16 = tid & 15, kvh = c16 >> 3, sub = c16 & 7;
    u32x4 qws[4], zws[4];
    if (wave < 2) attn_prefetch<true>(proj, MP + n * LS, wave * 4, lane, qws, zws);
    f32x4 kc[4][2], vc[4][2];
#pragma unroll
    for (int pass = 0; pass < 4; ++pass) {
        const int r = pass * 32 + (tid >> 4);
        kc[pass][0] = __builtin_nontemporal_load((const f32x4*)(ck + r * 128 + c16 * 8)); kc[pass][1] = __builtin_nontemporal_load((const f32x4*)(ck + r * 128 + c16 * 8 + 4));
        vc[pass][0] = __builtin_nontemporal_load((const f32x4*)(cv + r * 128 + c16 * 8)); vc[pass][1] = __builtin_nontemporal_load((const f32x4*)(cv + r * 128 + c16 * 8 + 4));
    }
#pragma unroll
    for (int pass = 0; pass < 4; ++pass) {
        const int r = pass * 32 + (tid >> 4);
        const f32x4 k0 = kc[pass][0], k1 = kc[pass][1], v0 = vc[pass][0], v1 = vc[pass][1];
        u32x4 kw; kw.x = pk_bf16(k0.x, k0.y); kw.y = pk_bf16(k0.z, k0.w); kw.z = pk_bf16(k1.x, k1.y); kw.w = pk_bf16(k1.z, k1.w);
        u32x4 vw; vw.x = pk_bf16(v0.x, v0.y); vw.y = pk_bf16(v0.z, v0.w); vw.z = pk_bf16(v1.x, v1.y); vw.w = pk_bf16(v1.z, v1.w);
        *(LAS u32x4*)(lds + kvh * KH + r * 144 + sub * 16) = kw;
        *(LAS u32x4*)(lds + VOFF + kvh * 2 * VH + (sub >> 2) * VH + r * 64 + (sub & 3) * 16) = vw;
        if (r >= 8) { float* pk = oks + (r - 8) * 128 + c16 * 8; float* pv = ovs + (r - 8) * 128 + c16 * 8;
            __builtin_nontemporal_store(k0, (f32x4*)pk); __builtin_nontemporal_store(k1, (f32x4*)(pk + 4)); __builtin_nontemporal_store(v0, (f32x4*)pv); __builtin_nontemporal_store(v1, (f32x4*)(pv + 4)); }
    }
    if (wave < 2) {
        const int t = tid >> 4; const size_t row = (size_t)MP + n * LS + t;
        const u32x4 kw = *(const u32x4*)(proj + row * PO2 + C_K + kvh * 64 + sub * 8);
        const u32x4 vw = *(const u32x4*)(proj + row * PO2 + C_V + kvh * 64 + sub * 8);
        float kf[8]; unpack8(kw, kf);
        normrope8(kf, sub, kg, tab + (size_t)(LP + t) * 16);
        *(LAS u32x4*)(lds + kvh * KH + (128 + t) * 144 + sub * 16) = pack8(kf);
        *(LAS u32x4*)(lds + VOFF + kvh * 2 * VH + (sub >> 2) * VH + (128 + t) * 64 + (sub & 3) * 16) = vw;
        float vf[8]; unpack8(vw, vf);
        float* pk = oks + (120 + t) * 128 + c16 * 8; float* pv = ovs + (120 + t) * 128 + c16 * 8;
        *(f32x4*)pk = (f32x4){kf[0], kf[1], kf[2], kf[3]}; *(f32x4*)(pk + 4) = (f32x4){kf[4], kf[5], kf[6], kf[7]};
        *(f32x4*)pv = (f32x4){vf[0], vf[1], vf[2], vf[3]}; *(f32x4*)(pv + 4) = (f32x4){vf[4], vf[5], vf[6], vf[7]};
    }
    for (int e = tid; e < 2 * 216 + 4 * 96; e += 512) {
        const u32x4 z = {0u, 0u, 0u, 0u};
        if (e < 432) { const int h = e / 216, c = e % 216; *(LAS u32x4*)(lds + h * KH + 136 * 144 + c * 16) = z; }
        else { const int e2 = e - 432, im = e2 / 96, c = e2 % 96; *(LAS u32x4*)(lds + VOFF + im * VH + 136 * 64 + c * 16) = z; }
    }
    __syncthreads();
    if (wave < 2) {
        const int h = wave;
        attn_tile32<true>(qws, zws, Y, tab, qg, sinks, lds + h * KH, lds + VOFF + h * 2 * VH, VH, wsf, ost, MP + n * LS, h * 4, LP, 0, lane);
    }
    __syncthreads();
}

__device__ __forceinline__ void conv_item(const Args& a, int l, int it, int lane, int wave) {
    const bf16_t* proj = (const bf16_t*)(a.ws + WS_PROJ); bf16_t* Y = (bf16_t*)(a.ws + WS_H);
    const int t0 = it * 64 + wave * 8, ch = lane * 8;
    const float* cw = a.in[11] + (size_t)l * 3 * 512 + ch;
    float w0[8], w1[8], w2[8];
    { const f32x4 a0 = *(const f32x4*)(cw), a1 = *(const f32x4*)(cw + 4), b0 = *(const f32x4*)(cw + 512), b1 = *(const f32x4*)(cw + 516), c0 = *(const f32x4*)(cw + 1024), c1 = *(const f32x4*)(cw + 1028);
      w0[0] = a0.x; w0[1] = a0.y; w0[2] = a0.z; w0[3] = a0.w; w0[4] = a1.x; w0[5] = a1.y; w0[6] = a1.z; w0[7] = a1.w;
      w1[0] = b0.x; w1[1] = b0.y; w1[2] = b0.z; w1[3] = b0.w; w1[4] = b1.x; w1[5] = b1.y; w1[6] = b1.z; w1[7] = b1.w;
      w2[0] = c0.x; w2[1] = c0.y; w2[2] = c0.z; w2[3] = c0.w; w2[4] = c1.x; w2[5] = c1.y; w2[6] = c1.z; w2[7] = c1.w; }
    u32x4 uw[8], gw[8];
#pragma unroll
    for (int i = 0; i < 8; ++i) { uw[i] = *(const u32x4*)(proj + (size_t)(t0 + i) * PO2 + C_U + ch); gw[i] = *(const u32x4*)(proj + (size_t)(t0 + i) * PO2 + C_GZ + ch); }
    float u2[8], u1[8];
    if (t0 < MP) {
        if ((t0 & (LP - 1)) == 0) {
#pragma unroll
            for (int i = 0; i < 8; ++i) { u2[i] = 0.f; u1[i] = 0.f; }
        } else {
            unpack8(*(const u32x4*)(proj + (size_t)(t0 - 2) * PO2 + C_U + ch), u2);
            unpack8(*(const u32x4*)(proj + (size_t)(t0 - 1) * PO2 + C_U + ch), u1);
        }
    } else {
        const int n = (t0 - MP) >> 3;
        const float* sc = a.in[4] + ((size_t)(l * NSB + n) * 2) * 512 + ch;
        const f32x4 a0 = *(const f32x4*)(sc), a1 = *(const f32x4*)(sc + 4), b0 = *(const f32x4*)(sc + 512), b1 = *(const f32x4*)(sc + 516);
        u2[0] = a0.x; u2[1] = a0.y; u2[2] = a0.z; u2[3] = a0.w; u2[4] = a1.x; u2[5] = a1.y; u2[6] = a1.z; u2[7] = a1.w;
        u1[0] = b0.x; u1[1] = b0.y; u1[2] = b0.z; u1[3] = b0.w; u1[4] = b1.x; u1[5] = b1.y; u1[6] = b1.z; u1[7] = b1.w;
    }
#pragma unroll
    for (int i = 0; i < 8; ++i) {
        float u0[8], gz[8], yv[8];
        unpack8(uw[i], u0); unpack8(gw[i], gz);
#pragma unroll
        for (int k = 0; k < 8; ++k) { yv[k] = gz[k] * (w0[k] * u2[k] + w1[k] * u1[k] + w2[k] * u0[k]); u2[k] = u1[k]; u1[k] = u0[k]; }
        *(u32x4*)(Y + (size_t)(t0 + i) * D + ch) = pack8(yv);
    }
    float* oc = nullptr;
    if (t0 < MP) { if ((t0 & (LP - 1)) == LP - 8) oc = a.out + O_CP + ((size_t)(l * NPB + (t0 >> 12)) * 2) * 512 + ch; }
    else oc = a.out + O_CS + ((size_t)(l * NSB + ((t0 - MP) >> 3)) * 2) * 512 + ch;
    if (oc) { *(f32x4*)oc = (f32x4){u2[0], u2[1], u2[2], u2[3]}; *(f32x4*)(oc + 4) = (f32x4){u2[4], u2[5], u2[6], u2[7]};
              *(f32x4*)(oc + 512) = (f32x4){u1[0], u1[1], u1[2], u1[3]}; *(f32x4*)(oc + 516) = (f32x4){u1[4], u1[5], u1[6], u1[7]}; }
}

__device__ __forceinline__ void p_mixer(const Args& a, int l, LAS unsigned char* lds, int tid, int lane, int wave, int bid, int G) {
    constexpr int N_AP = NPB * 32 * 2, N_AS = NSB, N_CV = M / 64;
    unsigned* head = (unsigned*)(a.ws + WS_BAR) + QUEUE_WORD + 64 * l;
    volatile LAS unsigned* slot = (volatile LAS unsigned*)(lds + 131072 + 128);
    const bool qfirst = ((bid >> 3) & 1) != 0;
    bool prompt_done = false, queue_empty = false; int pulled = 0;
#pragma unroll 1
    for (;;) {
        if (!prompt_done && (!qfirst || pulled >= 1 || queue_empty)) {
#pragma unroll 1
            for (int it = bid; it < N_AP; it += G) { asm volatile("" : "+v"(tid)); lane = tid & 63; attn_prompt_item(a, l, it, lds, tid, lane, wave); }
            prompt_done = true; continue;
        }
        if (queue_empty) break;
        if (threadIdx.x == 0) slot[0] = __hip_atomic_fetch_add(head, 1u, __ATOMIC_RELAXED, __HIP_MEMORY_SCOPE_AGENT);
        __syncthreads();
        const int q = (int)slot[0];
        __syncthreads();
        if (q >= N_AS + N_CV) { queue_empty = true; continue; }
        ++pulled;
        asm volatile("" : "+v"(tid)); lane = tid & 63;
        if (q < N_AS) attn_sample_item(a, l, q, lds, tid, lane, wave);
        else conv_item(a, l, q - N_AS, lane, wave);
    }
}

__device__ __forceinline__ void g2_sample_tile(const bf16_t* __restrict__ Y, const bf16_t* __restrict__ Wt, const float* xs  , const bf16_t* xbs  , float* outs  , bf16_t* outbs  , const float* __restrict__ gate,
                                               LAS unsigned char* lds, int tile, int tid, int lane, int wave) {
    const int row0 = (tile >> 4) * 64, col0 = (tile & 15) * 64, m = lane & 31, kq = lane >> 5;
    f32x16 acc[2][2];
#pragma unroll
    for (int i2 = 0; i2 < 2; ++i2)
#pragma unroll
        for (int j2 = 0; j2 < 2; ++j2)
#pragma unroll
            for (int i = 0; i < 16; ++i) acc[i2][j2][i] = 0.f;
    const bf16_t* ap = Y + (size_t)(MP + row0 + m) * D + wave * 128 + kq * 8;
    const bf16_t* bp = Wt + (size_t)(col0 + m) * D + wave * 128 + kq * 8;
#pragma unroll
    for (int ks = 0; ks < 8; ++ks) {
        const bf16x8 a0 = *(const bf16x8*)(ap + ks * 16), a1 = *(const bf16x8*)(ap + 32 * D + ks * 16), b0 = *(const bf16x8*)(bp + ks * 16), b1 = *(const bf16x8*)(bp + 32 * D + ks * 16);
        acc[0][0] = __builtin_amdgcn_mfma_f32_32x32x16_bf16(a0, b0, acc[0][0], 0, 0, 0); acc[0][1] = __builtin_amdgcn_mfma_f32_32x32x16_bf16(a0, b1, acc[0][1], 0, 0, 0);
        acc[1][0] = __builtin_amdgcn_mfma_f32_32x32x16_bf16(a1, b0, acc[1][0], 0, 0, 0); acc[1][1] = __builtin_amdgcn_mfma_f32_32x32x16_bf16(a1, b1, acc[1][1], 0, 0, 0);
    }
    LAS float* slab = (LAS float*)lds + wave * 4096;
#pragma unroll
    for (int i2 = 0; i2 < 2; ++i2)
#pragma unroll
        for (int j2 = 0; j2 < 2; ++j2)
#pragma unroll
            for (int i = 0; i < 16; ++i) slab[(32 * i2 + crow(i, kq)) * 64 + 32 * j2 + m] = acc[i2][j2][i];
    __syncthreads();
    const int r = tid >> 3, c8 = (tid & 7) * 8;
    f32x4 s0 = {0.f, 0.f, 0.f, 0.f}, s1 = {0.f, 0.f, 0.f, 0.f};
#pragma unroll
    for (int w = 0; w < 8; ++w) { const LAS float* sp = (const LAS float*)lds + w * 4096 + r * 64 + c8; s0 += *(const LAS f32x4*)sp; s1 += *(const LAS f32x4*)(sp + 4); }
    const int srow = row0 + r, nidx = NPB + (srow >> 3);
    const size_t ro = (size_t)srow * D + col0 + c8; const float* gp = gate + (size_t)nidx * 3072 + col0 + c8;
    const f32x4 g0 = *(const f32x4*)gp, g1 = *(const f32x4*)(gp + 4);
    f32x4 x0, x1;
    if (xs) { x0 = *(const f32x4*)(xs + ro); x1 = *(const f32x4*)(xs + ro + 4); }
    else { const u32x4 w = __builtin_nontemporal_load((const u32x4*)(xbs + ro));
        x0 = (f32x4){__uint_as_float(w.x << 16), __uint_as_float(w.x & 0xffff0000u), __uint_as_float(w.y << 16), __uint_as_float(w.y & 0xffff0000u)};
        x1 = (f32x4){__uint_as_float(w.z << 16), __uint_as_float(w.z & 0xffff0000u), __uint_as_float(w.w << 16), __uint_as_float(w.w & 0xffff0000u)}; }
    const f32x4 v0 = x0 + g0 * s0, v1 = x1 + g1 * s1;
    if (outbs) { u32x4 w; w.x = pk_bf16(v0[0], v0[1]); w.y = pk_bf16(v0[2], v0[3]); w.z = pk_bf16(v1[0], v1[1]); w.w = pk_bf16(v1[2], v1[3]); *(u32x4*)(outbs + ro) = w; }
    else { *(f32x4*)(outs + ro) = v0; *(f32x4*)(outs + ro + 4) = v1; }
    __syncthreads();
}

#define XB_TMO      128
#define XB_XCNT(j)  (256  + 64 * (j))
#define XB_XSUB(j)  (1280 + 64 * (j))
#define XB_XGEN(j)  (2304 + 64 * (j))
#define XB_TOP      3328
#define XB_TOPGEN   3392
#define XCD_BAR_WORDS 3456
#define XB_SPIN_CAP (1u << 18)

__device__ __forceinline__ unsigned xb_ld(unsigned* p)              { return __hip_atomic_load(p, __ATOMIC_RELAXED, __HIP_MEMORY_SCOPE_AGENT); }
__device__ __forceinline__ unsigned xb_add(unsigned* p, unsigned v) { return __hip_atomic_fetch_add(p, v, __ATOMIC_RELAXED, __HIP_MEMORY_SCOPE_AGENT); }
__device__ __forceinline__ unsigned xb_xcc_id() { return (unsigned)__builtin_amdgcn_s_getreg((3 << 11) | 20) & 0xFu; }
#define XB_SPIN(cond, bar) do { unsigned _sp = 0; while (cond) { __builtin_amdgcn_s_sleep(1); \
    if ((++_sp & 255u) == 0u) { if (xb_ld(&(bar)[XB_TMO])) break; if (_sp > XB_SPIN_CAP) { atomicAdd(&(bar)[XB_TMO], 1u); break; } } } } while (0)

struct XcdBarrier {
    unsigned* bar; unsigned x;
    volatile LAS unsigned* st;
};

__device__ __forceinline__ XcdBarrier xcd_barrier_post(unsigned* bar, volatile LAS unsigned* st) {
    XcdBarrier b; b.bar = bar; b.x = xb_xcc_id(); b.st = st;
    if (threadIdx.x == 0) (void)xb_add(&bar[XB_XCNT(b.x)], 1u);
    return b;
}
__device__ __forceinline__ void xcd_barrier_complete(unsigned* bar, unsigned x, unsigned& nloc, unsigned& nx) {
    const unsigned G = gridDim.x * gridDim.y * gridDim.z;
    unsigned sum, cnt, mine, sp = 0u;
    for (;;) {
        sum = 0u; cnt = 0u; mine = 0u;
#pragma unroll
        for (unsigned j = 0; j < 16; ++j) { const unsigned c = xb_ld(&bar[XB_XCNT(j)]); sum += c; cnt += (c > 0u) ? 1u : 0u; mine = (j == x) ? c : mine; }
        if (sum == G) break;
        __builtin_amdgcn_s_sleep(1);
        if ((++sp & 255u) == 0u) { if (xb_ld(&bar[XB_TMO])) break; if (sp > XB_SPIN_CAP) { atomicAdd(&bar[XB_TMO], 1u); break; } }
    }
    nloc = mine > 0u ? mine : 1u; nx = cnt > 0u ? cnt : 1u;
}

__device__ __forceinline__ void xcd_barrier(const XcdBarrier& b) {
    asm volatile("s_waitcnt vmcnt(0)" ::: "memory");
    __syncthreads();
    if (threadIdx.x == 0) {
        unsigned* bar = b.bar;
        __builtin_amdgcn_s_waitcnt(0);
        unsigned nloc = b.st[0], nx = b.st[1];
        if (nloc == 0u) { xcd_barrier_complete(bar, b.x, nloc, nx); b.st[0] = nloc; b.st[1] = nx; }
        const unsigned old = xb_add(&bar[XB_XSUB(b.x)], 1u);
        const unsigned gen = old / nloc;
        if (old + 1u == (gen + 1u) * nloc) {
            __builtin_amdgcn_fence(__ATOMIC_RELEASE, "agent");
            asm volatile("s_waitcnt vmcnt(0)" ::: "memory");
            const unsigned og = xb_add(&bar[XB_TOP], 1u);
            const unsigned tg = og / nx;
            if (og + 1u == (tg + 1u) * nx) xb_add(&bar[XB_TOPGEN], 1u);
            else XB_SPIN(xb_ld(&bar[XB_TOPGEN]) == tg, bar);
            __builtin_amdgcn_fence(__ATOMIC_ACQUIRE, "agent");
            xb_add(&bar[XB_XGEN(b.x)], 1u);
            asm volatile("s_waitcnt vmcnt(0)" ::: "memory");
        } else {
            XB_SPIN(xb_ld(&bar[XB_XGEN(b.x)]) == gen, bar);
            __builtin_amdgcn_fence(__ATOMIC_ACQUIRE, "agent");
            asm volatile("s_waitcnt vmcnt(0)" ::: "memory");
        }
    }
    __syncthreads();
}

__global__ void __launch_bounds__(512, 2) fwd_megakernel(Args a) {
    extern __shared__ __attribute__((aligned(16))) unsigned char lds_raw[];
    LAS unsigned char* lds = (LAS unsigned char*)lds_raw;
    cg::grid_group grid = cg::this_grid();
    const int bid = blockIdx.x, G = gridDim.x;
    if (threadIdx.x < 64) ((LAS unsigned*)(lds + 131072))[threadIdx.x] = 0u;
    __syncthreads();
    (void)xcd_barrier_post((unsigned*)(a.ws + WS_BAR), (volatile LAS unsigned*)(lds + 131072) + 8);
#define GRID_BARRIER() do { XcdBarrier xb_; xb_.bar = (unsigned*)(a.ws + WS_BAR); xb_.x = xb_xcc_id(); xb_.st = (volatile LAS unsigned*)(lds + 131072) + 8; xcd_barrier(xb_); } while (0)
#define FRESH_TID() int tid = threadIdx.x; asm volatile("" : "+v"(tid)); const int lane = tid & 63, wave = __builtin_amdgcn_readfirstlane(tid >> 6)
    if (a.ws == nullptr) grid.sync();
    { FRESH_TID(); p0_phase(a, lds, tid, lane, wave, bid, G); }
    GRID_BARRIER();
#pragma unroll 1
    for (int l = 0; l < 2; ++l) {
        { FRESH_TID(); (void)tid; p_norm(a, l, lane, wave, bid, G); }
#if DUP == 2
        { FRESH_TID(); (void)tid; p_norm(a, l, lane, wave, bid, G); }
#endif
        GRID_BARRIER();
        {
            pg8::Gemm g{(const bf16_t*)(a.ws + WS_H), (const bf16_t*)(a.ws + WS_WIN) + (size_t)l * PO * D, M, PO, D}; pg8::StaticOrder S; S.init(M, PO, G, bid);
            pg8::EpiProj E{(bf16_t*)(a.ws + WS_PROJ)};
            pg8::gemm_phase<pg8::EpiProj, pg8::StaticOrder, true, true>(lds, g, S, E);
#if DUP == 3
            pg8::gemm_phase<pg8::EpiProj, pg8::StaticOrder, true, true>(lds, g, S, E);
#endif
            constexpr int N_UNITS = (M / 256) * (PO / 256), N_FULL = N_UNITS % 256;
            if (l == 0) { if (G == 256 && bid >= N_FULL) { FRESH_TID(); (void)tid; transposes_layer(a, 1, lds, lane, wave, bid - N_FULL, 256 - N_FULL); }
                          else if (G != 256) { FRESH_TID(); (void)tid; transposes_layer(a, 1, lds, lane, wave, bid, G); } }
        }
        GRID_BARRIER();
        { FRESH_TID(); p_mixer(a, l, lds, tid, lane, wave, bid, G); }
#if DUP == 4
        { FRESH_TID(); p_mixer(a, l, lds, tid, lane, wave, bid, G); }
#endif
        GRID_BARRIER();
        {
            pg8::Gemm g{(const bf16_t*)(a.ws + WS_H), (const bf16_t*)(a.ws + WS_WOUT) + (size_t)l * D * D, MP, D, D}; pg8::StaticOrder S; S.init(MP, D, G, bid);
            const float* gate = (const float*)(a.ws + WS_MOD) + (size_t)l * NMOD * 3072 + 2048;
            bf16_t* XB = (bf16_t*)(a.ws + WS_XB);
            const bf16_t* XBase = (const bf16_t*)(a.ws + (l == 0 ? WS_XB0 : WS_XB));
            pg8::EpiGate E{nullptr, XBase, a.out, XB, gate, l == 0};
            const bool small_first = ((bid >> 3) & 1) != 0;
#pragma unroll 1
            for (int step = 0; step < 2; ++step) {
                if ((step == 0) == small_first) { FRESH_TID();
                    for (int t = bid; t < 256; t += G) g2_sample_tile((const bf16_t*)(a.ws + WS_H), (const bf16_t*)(a.ws + WS_WOUT) + (size_t)l * D * D, nullptr, XBase + (size_t)MP * D, a.out + (size_t)MP * D, l == 0 ? XB + (size_t)MP * D : nullptr, gate, lds, t, tid, lane, wave);
                } else {
                    pg8::gemm_phase<pg8::EpiGate, pg8::StaticOrder, true, true>(lds, g, S, E);
                }
            }
        }
        if (l == 0) GRID_BARRIER();
    }
}

extern "C" void kernel_launch(void* const* d_in, const int* in_sizes, int n_in, void* d_out, int out_size, void* d_ws, size_t ws_size, hipStream_t stream) {
    static int grid_blocks = 0;
    if (grid_blocks == 0) {
        if (n_in != 16 || out_size != (int)O_END || ws_size < WS_END) { fprintf(stderr, "kernel_launch: unexpected shapes n_in %d out %d ws %zu\n", n_in, out_size, ws_size); grid_blocks = -1; return; }
        int dev = 0, cus = 0, per_cu = 0;
        hipGetDevice(&dev);
        hipDeviceGetAttribute(&cus, hipDeviceAttributeMultiprocessorCount, dev);
        hipFuncSetAttribute((const void*)fwd_megakernel, hipFuncAttributeMaxDynamicSharedMemorySize, LDS_BYTES);
        hipOccupancyMaxActiveBlocksPerMultiprocessor(&per_cu, (const void*)fwd_megakernel, 512, LDS_BYTES);
        if (per_cu < 1) { fprintf(stderr, "kernel_launch: occupancy query says %d blocks per CU\n", per_cu); per_cu = 1; }
        if (per_cu > 1) per_cu = 1;
        grid_blocks = cus * per_cu;
    }
    if (grid_blocks < 0) return;
    Args a{};
    for (int i = 0; i < 16; ++i) a.in[i] = (const float*)d_in[i];
    a.out = (float*)d_out; a.ws = (unsigned char*)d_ws;
    if (hipMemsetAsync((char*)d_ws + WS_BAR, 0, BAR_BYTES, stream) != hipSuccess) { fprintf(stderr, "kernel_launch: memset of the barrier words failed\n"); return; }
    void* args[] = {&a};
    hipError_t e = hipLaunchCooperativeKernel((const void*)fwd_megakernel, dim3(grid_blocks), dim3(512), args, LDS_BYTES, stream);
    if (e != hipSuccess) fprintf(stderr, "cooperative launch failed: %s (grid %d)\n", hipGetErrorString(e), grid_blocks);
}
```

```cpp
#include <hip/hip_runtime.h>
#include <hip/hip_cooperative_groups.h>
#include <cstdio>
#include <cstdint>
namespace cg = cooperative_groups;
#ifndef DUP
#define DUP 0
#endif
namespace pg8 {
#define PG8_LAS __attribute__((address_space(3)))
typedef unsigned short bf16_t;
typedef short bf16x8 __attribute__((ext_vector_type(8)));
typedef float f32x4 __attribute__((ext_vector_type(4)));
typedef unsigned u32x4 __attribute__((ext_vector_type(4)));
constexpr int BM = 256, BK = 64, HALF = 128, HTB = HALF * BK * 2  , STAGE_BYTES = 8 * HTB, NXCD = 8, WGM = 8;

__host__ __device__ __forceinline__ int lds_byte(int r, int c) { const int st = (r >> 4) * 2 + (c >> 5), rr = r & 15, cc = c & 31, ob = rr * 64 + cc * 2; return st * 1024 + (ob ^ (((ob >> 9) & 1) << 5)); }
__host__ __device__ __forceinline__ void stage_rc(int b, int& R, int& C) { const int st = b / 1024, sb = b % 1024, swz = sb ^ (((sb >> 9) & 1) << 5); R = (st >> 1) * 16 + swz / 64; C = (st & 1) * 32 + (swz % 64) / 2; }
__host__ __device__ __forceinline__ int perm32(int rho) { const int n = rho >> 4, i = rho & 15; return 8 * (i >> 2) + 4 * n + (i & 3); }

struct Unit { int pm, pn; };
struct Gemm { const bf16_t* A; const bf16_t* Bt; int M, N, K; };

struct StaticOrder {
    int nM, nN, nwg, G, c;
    __host__ __device__ void init(int M, int N, int G_, int c_) { nM = M / BM; nN = N / BM; nwg = nM * nN; G = G_; c = c_; }
    __host__ __device__ bool next(int i, Unit& u) const {
        const long L = (long)i * G + c; if (L >= nwg) return false;
        int wgid = (int)L; { const int q = nwg / NXCD, r = nwg % NXCD, xcd = wgid % NXCD, off = wgid / NXCD; wgid = (xcd < r ? xcd * (q + 1) : r * (q + 1) + (xcd - r) * q) + off; }
        const int nig = WGM * nN, gid = wgid / nig, fm = gid * WGM, gsz = (nM - fm) < WGM ? (nM - fm) : WGM;
        u.pm = fm + ((wgid % nig) % gsz); u.pn = (wgid % nig) / gsz; return true;
    }
    __device__ __forceinline__ void a_ready(const Unit&) const {}
    __device__ __forceinline__ void done(const Unit&) const {}
};

__device__ __forceinline__ unsigned cvt_pk_bf16(float lo, float hi) { unsigned r; asm volatile("v_cvt_pk_bf16_f32 %0, %1, %2" : "=v"(r) : "v"(lo), "v"(hi)); return r; }
typedef float f32x2 __attribute__((ext_vector_type(2)));
__device__ __forceinline__ f32x2 gelu_pk(f32x2 v) {
    const f32x2 av = __builtin_elementwise_abs(v), d = av * 0.2316418882f + 1.0f;
    f32x2 t; t.x = __builtin_amdgcn_rcpf(d.x); t.y = __builtin_amdgcn_rcpf(d.y);
    f32x2 q = t * 0.5307027145f + (-0.7265760135f); q = q * t + 0.7107068705f; q = q * t + (-0.142248368f); q = q * t + 0.127414796f; q = q * t;
    const f32x2 s = (v * v) * (-0.72134752044f);
    f32x2 e; e.x = __builtin_amdgcn_exp2f(s.x); e.y = __builtin_amdgcn_exp2f(s.y);
    const f32x2 m = v * (q * e), r = v - m;
    f32x2 o; o.x = v.x < 0.f ? m.x : r.x; o.y = v.y < 0.f ? m.y : r.y; return o;
}

template <int ACT  > struct EpiBf16 {
    static constexpr bool PERM = true, AFTER_DRAIN = false; static_assert(ACT == 0 || ACT == 1, "EpiBf16: ACT is 0 (none) or 1 (gelu_pk)");
    bf16_t* O; int ldc; const float* bias; int split_cols; size_t split_stride; float scale0;
    __device__ __forceinline__ void operator()(const f32x4 (&acc)[2][2][4][2], const Unit& u, int wr, int wc, int fr, int fq) const {
        const int row0 = u.pm * BM + wr * 64 + fr; int colt = u.pn * BM; bf16_t* base = O;
        float sc = 1.f; if (split_cols) { const int t = colt / split_cols; base += (size_t)t * split_stride; colt -= t * split_cols; if (t == 0) sc = scale0; }
        const int col0 = colt + wc * 32 + 8 * fq, bcol0 = u.pn * BM + wc * 32 + 8 * fq;
        f32x4 bv[2][2];
#pragma unroll
        for (int bj = 0; bj < 2; ++bj)
#pragma unroll
            for (int n = 0; n < 2; ++n) bv[bj][n] = bias ? *(const f32x4*)(bias + bcol0 + bj * HALF + 4 * n) : (f32x4){0.f, 0.f, 0.f, 0.f};
#pragma unroll
        for (int ai = 0; ai < 2; ++ai)
#pragma unroll
            for (int m = 0; m < 4; ++m) { bf16_t* rowp = base + (size_t)(row0 + ai * HALF + m * 16) * ldc + col0;
#pragma unroll
                for (int bj = 0; bj < 2; ++bj) { f32x4 v0 = acc[ai][bj][m][0] + bv[bj][0], v1 = acc[ai][bj][m][1] + bv[bj][1];
                    if (ACT == 1) { f32x2 a = gelu_pk((f32x2){v0[0], v0[1]}), b = gelu_pk((f32x2){v0[2], v0[3]}), c = gelu_pk((f32x2){v1[0], v1[1]}), d = gelu_pk((f32x2){v1[2], v1[3]});
                        v0 = (f32x4){a.x, a.y, b.x, b.y}; v1 = (f32x4){c.x, c.y, d.x, d.y}; }
                    v0 = v0 * sc; v1 = v1 * sc; u32x4 w; w.x = cvt_pk_bf16(v0[0], v0[1]); w.y = cvt_pk_bf16(v0[2], v0[3]); w.z = cvt_pk_bf16(v1[0], v1[1]); w.w = cvt_pk_bf16(v1[2], v1[3]);
                    *(u32x4*)(rowp + bj * HALF) = w; } }
    }
};
template <class Epi, class Sched, bool ALIGN_EPI = false, bool SP2 = false>
__device__ __forceinline__ void gemm_phase(PG8_LAS unsigned char* lds, const Gemm g, const Sched& S, const Epi& E) {
    int tid_ = threadIdx.x; asm volatile("" : "+v"(tid_));
    const int tid = tid_, wid = __builtin_amdgcn_readfirstlane(tid >> 6), lane = tid & 63, wr = wid >> 2, wc = wid & 3, fr = lane & 15, fq = lane >> 4;
    const int K = g.K, nt = K / BK;
    unsigned voffA[2], voffB[2];
#pragma unroll
    for (int i = 0; i < 2; ++i) { int R, C; stage_rc(tid * 16 + i * 8192, R, C); const int Rb = Epi::PERM ? ((R & ~31) + perm32(R & 31)) : R;
        voffA[i] = (unsigned)(R * K + C) * 2u; voffB[i] = (unsigned)(Rb * K + C) * 2u; }
    const size_t kstep = (size_t)(BK * 2);
    const size_t hstep = (size_t)HALF * K * 2;
    const size_t tstep = 2 * hstep;
    const unsigned ldsw = (unsigned)wid * 1024u;
    const int aoff = lds_byte(wr * 64 + fr, fq * 8), boff = lds_byte(wc * 32 + fr, fq * 8);
#define PG8_SA(b, h) (((b) * 2 + (h)) * HTB)
#define PG8_SB(b, h) ((4 + (b) * 2 + (h)) * HTB)
#define PG8_STAGE(bufoff, gbase, voff) do { _Pragma("unroll") for (int _i = 0; _i < 2; ++_i) \
        __builtin_amdgcn_global_load_lds((const unsigned*)((const char*)(gbase) + (voff)[_i]), (PG8_LAS unsigned*)(lds + (bufoff) + ldsw + _i * 8192), 16, 0, 0); } while (0)
#define PG8_LDA(dst, b, h) do { _Pragma("unroll") for (int m = 0; m < 4; ++m) _Pragma("unroll") for (int k = 0; k < 2; ++k) dst[m][k] = *(const PG8_LAS bf16x8*)(lds + PG8_SA(b, h) + aoff + m * 2048 + k * 1024); } while (0)
#define PG8_LDB(dst, b, h) do { _Pragma("unroll") for (int n = 0; n < 2; ++n) _Pragma("unroll") for (int k = 0; k < 2; ++k) dst[n][k] = *(const PG8_LAS bf16x8*)(lds + PG8_SB(b, h) + boff + n * 2048 + k * 1024); } while (0)
#define PG8_MMA(ai, bj, At, Bt) do { __builtin_amdgcn_s_setprio(1); _Pragma("unroll") for (int m = 0; m < 4; ++m) _Pragma("unroll") for (int n = 0; n < 2; ++n) _Pragma("unroll") for (int k = 0; k < 2; ++k) \
        acc[ai][bj][m][n] = __builtin_amdgcn_mfma_f32_16x16x32_bf16(Bt[n][k], At[m][k], acc[ai][bj][m][n], 0, 0, 0); __builtin_amdgcn_s_setprio(0); } while (0)
#define PG8_WAIT_V(n) asm volatile("s_waitcnt vmcnt(" #n ")" ::: "memory")
#define PG8_WAIT_L(n) asm volatile("s_waitcnt lgkmcnt(" #n ")" ::: "memory")
#define PG8_BAR __builtin_amdgcn_s_barrier()
#define PG8_SCHED __builtin_amdgcn_sched_barrier(0)
    Unit cur, nxt; int ui = 0;
    if (!S.next(0, cur)) return;
    f32x4 acc[2][2][4][2];
#pragma unroll
    for (int a = 0; a < 2; ++a)
#pragma unroll
        for (int b = 0; b < 2; ++b)
#pragma unroll
            for (int m = 0; m < 4; ++m)
#pragma unroll
                for (int n = 0; n < 2; ++n) acc[a][b][m][n] = (f32x4){0.f, 0.f, 0.f, 0.f};
    bf16x8 At[4][2], B0[2][2], B1[2][2];
    const char* cA = (const char*)g.A + (size_t)cur.pm * tstep; const char* cB = (const char*)g.Bt + (size_t)cur.pn * tstep;
    S.a_ready(cur);
    if constexpr (SP2) {
        PG8_STAGE(PG8_SB(0, 0), cB, voffB); PG8_STAGE(PG8_SB(0, 1), cB + hstep, voffB); PG8_STAGE(PG8_SA(0, 0), cA, voffA); PG8_STAGE(PG8_SA(0, 1), cA + hstep, voffA);
        if (wr == 1) PG8_BAR;
        PG8_WAIT_V(2); PG8_BAR;
        PG8_STAGE(PG8_SB(1, 0), cB + kstep, voffB); PG8_STAGE(PG8_SA(1, 0), cA + kstep, voffA); PG8_STAGE(PG8_SB(1, 1), cB + hstep + kstep, voffB);
        PG8_WAIT_V(6); PG8_BAR;
    } else {
        PG8_STAGE(PG8_SB(0, 0), cB, voffB); PG8_STAGE(PG8_SA(0, 0), cA, voffA); PG8_STAGE(PG8_SB(0, 1), cB + hstep, voffB); PG8_STAGE(PG8_SA(0, 1), cA + hstep, voffA);
        if (wr == 1) PG8_BAR;
        PG8_WAIT_V(4); PG8_BAR;
        PG8_STAGE(PG8_SB(1, 0), cB + kstep, voffB); PG8_STAGE(PG8_SA(1, 0), cA + kstep, voffA); PG8_STAGE(PG8_SB(1, 1), cB + hstep + kstep, voffB);
        PG8_WAIT_V(6); PG8_BAR;
    }
    for (;;) {
        const bool has_next = S.next(ui + 1, nxt);
        const char* nA = has_next ? (const char*)g.A + (size_t)nxt.pm * tstep : cA; const char* nB = has_next ? (const char*)g.Bt + (size_t)nxt.pn * tstep : cB;
        for (int t = 0; t < nt; t += 2) {
            const bool last = (t == nt - 2);
            const char* a1 = cA + (size_t)(t + 1) * kstep;
            const char* a2 = last ? nA : cA + (size_t)(t + 2) * kstep; const char* b2 = last ? nB : cB + (size_t)(t + 2) * kstep;
            const char* a3 = a2 + kstep; const char* b3 = b2 + kstep;
            if (last && has_next) S.a_ready(nxt);
            if constexpr (SP2) {
            PG8_LDB(B0, 0, 0); PG8_LDB(B1, 0, 1); PG8_SCHED; PG8_LDA(At, 0, 0); PG8_STAGE(PG8_SA(1, 1), a1 + hstep, voffA);
            PG8_WAIT_V(8); PG8_WAIT_L(0); PG8_BAR; PG8_MMA(0, 0, At, B0); PG8_MMA(0, 1, At, B1); PG8_BAR; PG8_SCHED;
            PG8_LDA(At, 0, 1); PG8_STAGE(PG8_SB(0, 0), b2, voffB); PG8_STAGE(PG8_SB(0, 1), b2 + hstep, voffB); PG8_STAGE(PG8_SA(0, 0), a2, voffA);
            PG8_WAIT_V(8); PG8_WAIT_L(0); PG8_BAR; PG8_MMA(1, 0, At, B0); PG8_MMA(1, 1, At, B1); PG8_BAR; PG8_SCHED;
            PG8_LDB(B0, 1, 0); PG8_LDB(B1, 1, 1); PG8_SCHED; PG8_LDA(At, 1, 0); PG8_STAGE(PG8_SA(0, 1), a2 + hstep, voffA);
            PG8_WAIT_V(8); PG8_WAIT_L(0); PG8_BAR; PG8_MMA(0, 0, At, B0); PG8_MMA(0, 1, At, B1); PG8_BAR; PG8_SCHED;
            PG8_LDA(At, 1, 1); PG8_STAGE(PG8_SB(1, 0), b3, voffB); PG8_STAGE(PG8_SB(1, 1), b3 + hstep, voffB); PG8_STAGE(PG8_SA(1, 0), a3, voffA);
            PG8_WAIT_V(8); PG8_WAIT_L(0); PG8_BAR; PG8_MMA(1, 0, At, B0); PG8_MMA(1, 1, At, B1); PG8_BAR; PG8_SCHED;
            } else {
            PG8_LDB(B0, 0, 0); PG8_SCHED; PG8_LDA(At, 0, 0); PG8_STAGE(PG8_SA(1, 1), a1 + hstep, voffA);
            PG8_WAIT_L(8); PG8_BAR; PG8_WAIT_L(0); PG8_MMA(0, 0, At, B0); PG8_BAR; PG8_SCHED;
            PG8_LDB(B1, 0, 1); PG8_STAGE(PG8_SB(0, 0), b2, voffB);
            PG8_BAR; PG8_WAIT_L(0); PG8_MMA(0, 1, At, B1); PG8_BAR;
            PG8_LDA(At, 0, 1); PG8_STAGE(PG8_SA(0, 0), a2, voffA);
            PG8_BAR; PG8_WAIT_L(0); PG8_MMA(1, 0, At, B0); PG8_BAR; PG8_SCHED;
            PG8_STAGE(PG8_SB(0, 1), b2 + hstep, voffB);
            PG8_WAIT_V(6); PG8_BAR; PG8_MMA(1, 1, At, B1); PG8_BAR;
            PG8_LDB(B0, 1, 0); PG8_SCHED; PG8_LDA(At, 1, 0); PG8_STAGE(PG8_SA(0, 1), a2 + hstep, voffA);
            PG8_WAIT_L(8); PG8_BAR; PG8_WAIT_L(0); PG8_MMA(0, 0, At, B0); PG8_BAR; PG8_SCHED;
            PG8_LDB(B1, 1, 1); PG8_STAGE(PG8_SB(1, 0), b3, voffB);
            PG8_BAR; PG8_WAIT_L(0); PG8_MMA(0, 1, At, B1); PG8_BAR;
            PG8_LDA(At, 1, 1); PG8_STAGE(PG8_SA(1, 0), a3, voffA);
            PG8_BAR; PG8_WAIT_L(0); PG8_MMA(1, 0, At, B0); PG8_BAR; PG8_SCHED;
            PG8_STAGE(PG8_SB(1, 1), b3 + hstep, voffB);
            PG8_WAIT_V(6); PG8_BAR; PG8_MMA(1, 1, At, B1); PG8_BAR;
            }
        }
        if constexpr (ALIGN_EPI) { if (wr == 0) PG8_BAR; }
        if constexpr (!Epi::AFTER_DRAIN) { E(acc, cur, wr, wc, fr, fq); S.done(cur); }
        if (!has_next) break;
#pragma unroll
        for (int a = 0; a < 2; ++a)
#pragma unroll
            for (int b = 0; b < 2; ++b)
#pragma unroll
                for (int m = 0; m < 4; ++m)
#pragma unroll
                    for (int n = 0; n < 2; ++n) acc[a][b][m][n] = (f32x4){0.f, 0.f, 0.f, 0.f};
        cur = nxt; cA = nA; cB = nB; ++ui;
        if constexpr (ALIGN_EPI) { if (wr == 1) PG8_BAR; }
    }
    PG8_WAIT_V(0);
    if constexpr (!ALIGN_EPI) { if (wr == 0) PG8_BAR; }
    PG8_BAR;
    if constexpr (Epi::AFTER_DRAIN) { E.fused(acc, cur, wr, wc, fr, fq, lds, wid, lane); S.done(cur); }
#undef PG8_SA
#undef PG8_SB
#undef PG8_STAGE
#undef PG8_LDA
#undef PG8_LDB
#undef PG8_MMA
#undef PG8_WAIT_V
#undef PG8_WAIT_L
#undef PG8_BAR
#undef PG8_SCHED
}
}

#define LAS __attribute__((address_space(3)))
typedef unsigned short bf16_t;
typedef float f32x4 __attribute__((ext_vector_type(4)));
typedef float f32x16 __attribute__((ext_vector_type(16)));
typedef unsigned u32x4 __attribute__((ext_vector_type(4)));
typedef unsigned u32x2 __attribute__((ext_vector_type(2)));
typedef short bf16x8 __attribute__((ext_vector_type(8)));
typedef short s16x4 __attribute__((ext_vector_type(4)));
typedef short v4i16_t __attribute__((ext_vector_type(4)));

constexpr int D = 1024, NPB = 4, LP = 4096, NSB = 128, LS = 8;
constexpr int MP = NPB * LP, MS = NSB * LS, M = MP + MS;
constexpr int PO = 3328;
constexpr int PO2 = 2304;
constexpr int C_U = 0, C_GZ = 512, C_Q = 1024, C_K = 1536, C_V = 1664, C_ZA = 1792;
constexpr int NMOD = NPB + NSB;
constexpr float EPS = 1e-6f;
constexpr float LOG2E = 1.4426950408889634f;
constexpr size_t O_YP = 0, O_YS = (size_t)MP * D, O_CP = O_YS + (size_t)MS * D, O_KP = O_CP + 2 * NPB * 2 * 512, O_VP = O_KP + 2 * NPB * 128 * 128,
                 O_CS = O_VP + 2 * NPB * 128 * 128, O_KS = O_CS + 2 * NSB * 2 * 512, O_VS = O_KS + (size_t)2 * NSB * 128 * 128, O_END = O_VS + (size_t)2 * NSB * 128 * 128;
static_assert(O_END == 26746880, "output size");
constexpr size_t MiB = 1u << 20;
constexpr size_t WS_WIN = 0, WS_WOUT = 14 * MiB, WS_MOD = 18 * MiB, WS_ROPE = 22 * MiB, WS_H = 24 * MiB, WS_PROJ = 58 * MiB, WS_XB = 170 * MiB, WS_XB0 = 204 * MiB, WS_END = 238 * MiB;
static_assert((size_t)2 * PO * D * 2 <= WS_WOUT && WS_H + (size_t)M * D * 2 <= WS_PROJ && WS_PROJ + (size_t)M * PO * 2 <= WS_XB && WS_XB + (size_t)M * D * 2 <= WS_XB0 && WS_XB0 + (size_t)M * D * 2 <= WS_END, "ws map");
constexpr size_t WS_SILU = 22 * MiB + 512 * 1024;
constexpr size_t WS_BAR = 23 * MiB, BAR_BYTES = 16384;
constexpr int QUEUE_WORD = 3584;
constexpr int LDS_BYTES = 131072 + 1024;

struct Args { const float* in[16]; float* out; unsigned char* ws; };

__device__ __forceinline__ unsigned pk_bf16(float lo, float hi) { typedef float f2 __attribute__((ext_vector_type(2))); typedef __bf16 b2 __attribute__((ext_vector_type(2)));
    f2 v = {lo, hi}; b2 b = __builtin_convertvector(v, b2); return __builtin_bit_cast(unsigned, b); }
__device__ __forceinline__ void unpack8(const u32x4 w, float (&f)[8]) {
    f[0] = __uint_as_float(w.x << 16); f[1] = __uint_as_float(w.x & 0xffff0000u); f[2] = __uint_as_float(w.y << 16); f[3] = __uint_as_float(w.y & 0xffff0000u);
    f[4] = __uint_as_float(w.z << 16); f[5] = __uint_as_float(w.z & 0xffff0000u); f[6] = __uint_as_float(w.w << 16); f[7] = __uint_as_float(w.w & 0xffff0000u); }
__device__ __forceinline__ u32x4 pack8(const float (&f)[8]) { u32x4 w; w.x = pk_bf16(f[0], f[1]); w.y = pk_bf16(f[2], f[3]); w.z = pk_bf16(f[4], f[5]); w.w = pk_bf16(f[6], f[7]); return w; }
constexpr float LOG2E_ = 1.4426950408889634f;
__device__ __forceinline__ float silu_f(float v) { return v * __builtin_amdgcn_rcpf(1.0f + __builtin_amdgcn_exp2f(-v * LOG2E_)); }
__device__ __forceinline__ int crow(int r, int hi) { return (r & 3) + 8 * (r >> 2) + 4 * hi; }
__device__ __forceinline__ float wave_sum(float v) {
#pragma unroll
    for (int o = 1; o < 64; o <<= 1) v += __shfl_xor(v, o);
    return v;
}

namespace pg8 {
struct EpiGate {
    static constexpr bool PERM = true, AFTER_DRAIN = false;
    const float* xf; const bf16_t* xb;
    float* outf; bf16_t* outb;
    const float* gate;
    bool first;
    __device__ __forceinline__ void operator()(const f32x4 (&acc)[2][2][4][2], const Unit& u, int wr, int wc, int fr, int fq) const {
        const int col0 = u.pn * BM + wc * 32 + 8 * fq;
        const float* gp = gate + (size_t)(u.pm >> 4) * 3072 + col0;
        const bool l0 = first;
        f32x4 gv[2][2];
#pragma unroll
        for (int bj = 0; bj < 2; ++bj)
#pragma unroll
            for (int nn = 0; nn < 2; ++nn) gv[bj][nn] = *(const f32x4*)(gp + bj * HALF + nn * 4);
#pragma unroll
        for (int ai = 0; ai < 2; ++ai) {
            u32x4 xw[4][2];
#pragma unroll
            for (int mi = 0; mi < 4; ++mi) { const bf16_t* bp = xb + (size_t)(u.pm * BM + ai * HALF + wr * 64 + mi * 16 + fr) * 1024 + col0;
#pragma unroll
                for (int bj = 0; bj < 2; ++bj) xw[mi][bj] = __builtin_nontemporal_load((const u32x4*)(bp + bj * HALF)); }
#pragma unroll
            for (int mi = 0; mi < 4; ++mi) { const size_t ro = (size_t)(u.pm * BM + ai * HALF + wr * 64 + mi * 16 + fr) * 1024 + col0;
#pragma unroll
                for (int bj = 0; bj < 2; ++bj) { const u32x4 w = xw[mi][bj];
                    const f32x4 x0 = (f32x4){__uint_as_float(w.x << 16), __uint_as_float(w.x & 0xffff0000u), __uint_as_float(w.y << 16), __uint_as_float(w.y & 0xffff0000u)};
                    const f32x4 x1 = (f32x4){__uint_as_float(w.z << 16), __uint_as_float(w.z & 0xffff0000u), __uint_as_float(w.w << 16), __uint_as_float(w.w & 0xffff0000u)};
                    const f32x4 v0 = x0 + gv[bj][0] * acc[ai][bj][mi][0], v1 = x1 + gv[bj][1] * acc[ai][bj][mi][1];
                    if (l0) { u32x4 o; o.x = cvt_pk_bf16(v0[0], v0[1]); o.y = cvt_pk_bf16(v0[2], v0[3]); o.z = cvt_pk_bf16(v1[0], v1[1]); o.w = cvt_pk_bf16(v1[2], v1[3]);
                              *(u32x4*)(outb + ro + bj * HALF) = o; }
                    else { __builtin_nontemporal_store(v0, (f32x4*)(outf + ro + bj * HALF)); __builtin_nontemporal_store(v1, (f32x4*)(outf + ro + bj * HALF + 4)); }
                } }
        }
    }
};
}


namespace pg8 {
struct EpiProj {
    static constexpr bool PERM = true, AFTER_DRAIN = false;
    bf16_t* O;
    __device__ __forceinline__ void operator()(const f32x4 (&acc)[2][2][4][2], const Unit& u, int wr, int wc, int fr, int fq) const {
        const int row0 = u.pm * BM + wr * 64 + fr;
        if (u.pn < 8) {
            const bool bz = u.pn >= 4;
            const int col0 = (bz ? 512 + (u.pn - 4) * 128 : u.pn * 128) + wc * 32 + 8 * fq;
#pragma unroll
            for (int ai = 0; ai < 2; ++ai)
#pragma unroll
                for (int m = 0; m < 4; ++m) {
                    const f32x4 a0 = acc[ai][0][m][0], a1 = acc[ai][0][m][1], b0 = acc[ai][1][m][0], b1 = acc[ai][1][m][1];
                    f32x4 v0, v1;
                    if (bz) { v0 = (f32x4){a0[0] * silu_f(b0[0]), a0[1] * silu_f(b0[1]), a0[2] * silu_f(b0[2]), a0[3] * silu_f(b0[3])};
                              v1 = (f32x4){a1[0] * silu_f(b1[0]), a1[1] * silu_f(b1[1]), a1[2] * silu_f(b1[2]), a1[3] * silu_f(b1[3])}; }
                    else { v0 = a0 * b0; v1 = a1 * b1; }
                    u32x4 w; w.x = cvt_pk_bf16(v0[0], v0[1]); w.y = cvt_pk_bf16(v0[2], v0[3]); w.z = cvt_pk_bf16(v1[0], v1[1]); w.w = cvt_pk_bf16(v1[2], v1[3]);
                    *(u32x4*)(O + (size_t)(row0 + ai * HALF + m * 16) * PO2 + col0) = w;
                }
        } else {
            const int col0 = u.pn * BM - 1024 + wc * 32 + 8 * fq;
            const bool za = u.pn >= 11;
#pragma unroll
            for (int ai = 0; ai < 2; ++ai)
#pragma unroll
                for (int m = 0; m < 4; ++m) { bf16_t* rowp = O + (size_t)(row0 + ai * HALF + m * 16) * PO2 + col0;
#pragma unroll
                    for (int bj = 0; bj < 2; ++bj) { f32x4 v0 = acc[ai][bj][m][0], v1 = acc[ai][bj][m][1];
                        if (za) { v0 = (f32x4){silu_f(v0[0]), silu_f(v0[1]), silu_f(v0[2]), silu_f(v0[3])}; v1 = (f32x4){silu_f(v1[0]), silu_f(v1[1]), silu_f(v1[2]), silu_f(v1[3])}; }
                        u32x4 w; w.x = cvt_pk_bf16(v0[0], v0[1]); w.y = cvt_pk_bf16(v0[2], v0[3]); w.z = cvt_pk_bf16(v1[0], v1[1]); w.w = cvt_pk_bf16(v1[2], v1[3]);
                        *(u32x4*)(rowp + bj * HALF) = w; } }
        }
    }
};
}

__device__ __forceinline__ unsigned f2bf_rne(float f) { unsigned u = __float_as_uint(f); return (u + 0x7fffu + ((u >> 16) & 1u)) >> 16; }
__device__ __forceinline__ unsigned pk2(float lo, float hi) { return f2bf_rne(lo) | (f2bf_rne(hi) << 16); }
__device__ __forceinline__ int win_row_of_col(int c) {
    if (c >= 2048) return c;
    const int grp = c >> 9, cc = c & 511, t = cc >> 7, j = cc & 127;
    return (grp == 1) ? 256 * t + j : (grp == 2) ? 256 * t + 128 + j : (grp == 0) ? 256 * (4 + t) + j : 256 * (4 + t) + 128 + j;
}
template <bool REMAP>
__device__ __forceinline__ void p0_transpose_item(const float* W, int K, int N, bf16_t* WT, LAS float* scr, int item, int lane) {
    const int nblk = N / 32, kb = item / nblk, nb = item % nblk, k0 = 64 * kb, n0 = 32 * nb;
    const int r0 = REMAP ? win_row_of_col(n0) : n0;
#pragma unroll
    for (int i = 0; i < 32; ++i) { const int kk = 2 * i + (lane >> 5); scr[kk * 33 + (lane & 31)] = __builtin_nontemporal_load(W + (size_t)(k0 + kk) * N + n0 + (lane & 31)); }
    asm volatile("s_waitcnt lgkmcnt(0)" ::: "memory");
    const int c = lane & 7;
#pragma unroll
    for (int j = 0; j < 4; ++j) { const int n = (lane >> 3) + 8 * j; const LAS float* s = scr + (8 * c) * 33 + n;
        u32x4 o; o.x = pk2(s[0 * 33], s[1 * 33]); o.y = pk2(s[2 * 33], s[3 * 33]); o.z = pk2(s[4 * 33], s[5 * 33]); o.w = pk2(s[6 * 33], s[7 * 33]);
        *(u32x4*)(WT + (size_t)(r0 + n) * K + k0 + 8 * c) = o; }
    asm volatile("s_waitcnt lgkmcnt(0)" ::: "memory");
}

__device__ __forceinline__ void p0_silu_table(const Args& a, int tid, int bid, int G) {
    u32x4* tabs = (u32x4*)(a.ws + WS_SILU);
    for (int e = bid * 512 + tid; e < 5 * 64 * 64; e += G * 512) {
        const int ln = e & 63, ks = (e >> 6) & 63, rt = e >> 12;
        const int row = 32 * rt + (ln & 31), k0 = 16 * ks + 8 * (ln >> 5);
        u32x4 pw = {0u, 0u, 0u, 0u};
        if (row < NMOD) {
            const float* cp = row < NPB ? a.in[2] + (size_t)row * D : a.in[3] + (size_t)(row - NPB) * D;
            const f32x4 c0 = *(const f32x4*)(cp + k0), c1 = *(const f32x4*)(cp + k0 + 4);
            float cv[8] = {silu_f(c0.x), silu_f(c0.y), silu_f(c0.z), silu_f(c0.w), silu_f(c1.x), silu_f(c1.y), silu_f(c1.z), silu_f(c1.w)};
            pw = pack8(cv);
        }
        tabs[e] = pw;
    }
}
__device__ __forceinline__ void p0_mod_item(const Args& a, LAS unsigned char* lds, int it, int tid, int lane, int wave) {
    const int l = it / 96, col0 = (it % 96) * 32;
    const float* W = a.in[7] + (size_t)l * D * 3072;
    const int n = lane & 31, kq = lane >> 5;
    f32x16 acc[5];
#pragma unroll
    for (int rt = 0; rt < 5; ++rt)
#pragma unroll
        for (int i = 0; i < 16; ++i) acc[rt][i] = 0.f;
    const u32x4* tabs = (const u32x4*)(a.ws + WS_SILU) + (size_t)(wave * 8) * 64 + lane;
    const float* wp = W + (size_t)(wave * 128 + 8 * kq) * 3072 + col0 + n;
#pragma unroll 1
    for (int kp = 0; kp < 4; ++kp) {
        float wv[2][8]; u32x4 af[2][5];
#pragma unroll
        for (int h = 0; h < 2; ++h) {
#pragma unroll
            for (int j = 0; j < 8; ++j) wv[h][j] = __builtin_nontemporal_load(wp + (size_t)(h * 16 + j) * 3072);
#pragma unroll
            for (int rt = 0; rt < 5; ++rt) af[h][rt] = tabs[(rt * 64 + h) * 64];
        }
#pragma unroll
        for (int h = 0; h < 2; ++h) {
            const bf16x8 bfrag = __builtin_bit_cast(bf16x8, pack8(wv[h]));
#pragma unroll
            for (int rt = 0; rt < 5; ++rt) acc[rt] = __builtin_amdgcn_mfma_f32_32x32x16_bf16(__builtin_bit_cast(bf16x8, af[h][rt]), bfrag, acc[rt], 0, 0, 0);
        }
        wp += (size_t)32 * 3072; tabs += 2 * 64;
    }
    LAS float* red = (LAS float*)lds;
    LAS float* rb = red + (4 * kq) * 32 + n;
#pragma unroll 1
    for (int w = 0; w < 8; ++w) {
        if (wave == w) {
#pragma unroll
            for (int rt = 0; rt < 5; ++rt)
#pragma unroll
                for (int i = 0; i < 16; ++i) { const int off = (32 * rt + (i & 3) + 8 * (i >> 2)) * 32; const float prev = (w == 0) ? 0.f : rb[off]; rb[off] = prev + acc[rt][i]; }
        }
        __syncthreads();
    }
    float* mod = (float*)(a.ws + WS_MOD);
    const float* bm = a.in[8] + (size_t)l * 3072;
    for (int e = tid; e < NMOD * 32; e += 512) { const int row = e >> 5, c = e & 31; mod[((size_t)l * NMOD + row) * 3072 + col0 + c] = red[e] + bm[col0 + c]; }
    __syncthreads();
}

__device__ __forceinline__ void transposes_layer(const Args& a, int l, LAS unsigned char* lds, int lane, int wave, int vrot, int nvb) {
    LAS float* scr = (LAS float*)(lds + wave * 16384);
    constexpr int I_IN = (D / 64) * (PO / 32), I_OUT = (D / 64) * (D / 32);
    bf16_t* WinT = (bf16_t*)(a.ws + WS_WIN) + (size_t)l * PO * D; bf16_t* WoutT = (bf16_t*)(a.ws + WS_WOUT) + (size_t)l * D * D;
    for (int it = vrot * 8 + wave; it < I_IN + I_OUT; it += nvb * 8) {
        if (it < I_IN) p0_transpose_item<true>(a.in[10] + (size_t)l * D * PO, D, PO, WinT, scr, it, lane);
        else p0_transpose_item<false>(a.in[15] + (size_t)l * D * D, D, D, WoutT, scr, it - I_IN, lane);
    }
    __syncthreads();
}
__device__ __forceinline__ void p0_rope(const Args& a, int tid, int bid, int G) {
    float* tab = (float*)(a.ws + WS_ROPE);
    for (int e = bid * 512 + tid; e < (LP + LS) * 8; e += G * 512) {
        const int p = e >> 3, j = e & 7;
        const float pos = (float)(p < LP ? p : 8192 + (p - LP));
        const float inv = (float)exp(-(double)j * 1.640295422175541);
        const float angf = pos * inv;
        const double ang = (double)angf;
        const double twopi = 6.283185307179586476925;
        const double kk = __builtin_rint(ang / twopi);
        const float red = (float)(ang - kk * twopi);
        tab[p * 16 + j] = cosf(red); tab[p * 16 + 8 + j] = sinf(red);
    }
}

constexpr int FLAG_WORD = QUEUE_WORD + 128;
__device__ __forceinline__ void p0_phase(const Args& a, LAS unsigned char* lds, int tid, int lane, int wave, int bid, int G) {
    unsigned* flag = (unsigned*)(a.ws + WS_BAR) + FLAG_WORD;
    constexpr int NENT = 5 * 64 * 64;
    const int nprod = (NENT + 511) / 512 < G ? (NENT + 511) / 512 : G;
    p0_silu_table(a, tid, bid, G);
    if (bid < nprod) {
        asm volatile("s_waitcnt vmcnt(0)" ::: "memory");
        __syncthreads();
        if (tid == 0) { __builtin_amdgcn_fence(__ATOMIC_RELEASE, "agent"); asm volatile("s_waitcnt vmcnt(0)" ::: "memory");
                        __hip_atomic_fetch_add(flag, 1u, __ATOMIC_RELAXED, __HIP_MEMORY_SCOPE_AGENT); }
    }
    p0_rope(a, tid, bid, G);
    {
        const int nmod = G < 192 ? G : 192;
        const int vrot = (bid >= nmod) ? bid - nmod : bid + (G - nmod);
        transposes_layer(a, 0, lds, lane, wave, vrot, G);
    }
    if (bid < 192 || G < 192) {
        if (tid == 0) {
            unsigned sp = 0;
            while (__hip_atomic_load(flag, __ATOMIC_RELAXED, __HIP_MEMORY_SCOPE_AGENT) < (unsigned)nprod) { __builtin_amdgcn_s_sleep(2); if (++sp > (1u << 22)) break; }
            __builtin_amdgcn_fence(__ATOMIC_ACQUIRE, "agent"); asm volatile("s_waitcnt vmcnt(0)" ::: "memory");
        }
        __syncthreads();
        asm volatile("" : "+v"(tid)); lane = tid & 63;
        for (int it = bid; it < 192; it += G) p0_mod_item(a, lds, it, tid, lane, wave);
    }
    {
        unsigned* head = (unsigned*)(a.ws + WS_BAR) + QUEUE_WORD + 192;
        volatile LAS unsigned* slot = (volatile LAS unsigned*)(lds + 131072 + 128);
        bf16_t* XB0 = (bf16_t*)(a.ws + WS_XB0);
        for (;;) {
            if (threadIdx.x == 0) slot[0] = __hip_atomic_fetch_add(head, 1u, __ATOMIC_RELAXED, __HIP_MEMORY_SCOPE_AGENT);
            __syncthreads();
            const int q = (int)slot[0];
            __syncthreads();
            if (q >= M / 64) break;
            asm volatile("" : "+v"(tid)); lane = tid & 63;
            f32x4 v[8][4];
#pragma unroll
            for (int r = 0; r < 8; ++r) { const int row = q * 64 + wave * 8 + r;
                const float* xrow = row < MP ? a.in[0] + (size_t)row * D : a.in[1] + (size_t)(row - MP) * D;
#pragma unroll
                for (int j = 0; j < 4; ++j) v[r][j] = __builtin_nontemporal_load((const f32x4*)xrow + 64 * j + lane); }
#pragma unroll
            for (int r = 0; r < 8; ++r) { const int row = q * 64 + wave * 8 + r;
#pragma unroll
                for (int j = 0; j < 4; ++j) { u32x2 o; o.x = pk_bf16(v[r][j].x, v[r][j].y); o.y = pk_bf16(v[r][j].z, v[r][j].w); *((u32x2*)(XB0 + (size_t)row * D) + 64 * j + lane) = o; } }
        }
    }
}
__device__ __forceinline__ void p_norm(const Args& a, int l, int lane, int wave, int bid, int G) {
    const int gw = bid * 8 + wave, NGW = G * 8;
    const float* mod = (const float*)(a.ws + WS_MOD) + (size_t)l * NMOD * 3072;
    const float* g = a.in[9] + (size_t)l * D;
    bf16_t* H = (bf16_t*)(a.ws + WS_H);
    const bf16_t* X = (const bf16_t*)(a.ws + (l == 0 ? WS_XB0 : WS_XB));
#define NORM_LOAD(V, ROW) do { const u32x2* xr_ = (const u32x2*)(X + (size_t)(ROW) * D); _Pragma("unroll") for (int j = 0; j < 4; ++j) { const u32x2 w_ = xr_[64 * j + lane]; \
        V[j] = (f32x4){__uint_as_float(w_.x << 16), __uint_as_float(w_.x & 0xffff0000u), __uint_as_float(w_.y << 16), __uint_as_float(w_.y & 0xffff0000u)}; } } while (0)
#define NORM_FINISH(V, ROW, GS, SH) do { float ss_ = 0.f; _Pragma("unroll") for (int j = 0; j < 4; ++j) ss_ += (V[j].x * V[j].x + V[j].y * V[j].y) + (V[j].z * V[j].z + V[j].w * V[j].w); \
        const float rstd_ = rsqrtf(wave_sum(ss_) * (1.0f / D) + EPS); \
        _Pragma("unroll") for (int j = 0; j < 4; ++j) { const f32x4 h_ = V[j] * rstd_ * GS[j] + SH[j]; u32x2 o_; o_.x = pk_bf16(h_.x, h_.y); o_.y = pk_bf16(h_.z, h_.w); \
            *((u32x2*)(H + (size_t)(ROW) * D) + 64 * j + lane) = o_; } } while (0)
#pragma unroll 1
    for (int n = 0; n < NPB; ++n) {
        const float* mp = mod + (size_t)n * 3072;
        f32x4 gs[4], sh[4];
#pragma unroll
        for (int j = 0; j < 4; ++j) { gs[j] = *((const f32x4*)g + 64 * j + lane) * (*((const f32x4*)(mp + D) + 64 * j + lane) + 1.0f); sh[j] = *((const f32x4*)mp + 64 * j + lane); }
#pragma unroll 1
        for (int r0 = gw; r0 < LP; r0 += 3 * NGW) {
            f32x4 v0[4], v1[4], v2[4];
            const int ra = n * LP + r0, rb = ra + NGW, rc = rb + NGW;
            const bool hb = r0 + NGW < LP, hc = r0 + 2 * NGW < LP;
            NORM_LOAD(v0, ra); if (hb) NORM_LOAD(v1, rb); if (hc) NORM_LOAD(v2, rc);
            NORM_FINISH(v0, ra, gs, sh); if (hb) NORM_FINISH(v1, rb, gs, sh); if (hc) NORM_FINISH(v2, rc, gs, sh);
        }
    }
#pragma unroll 1
    for (int row = MP + gw; row < M; row += NGW) {
        const float* mp = mod + (size_t)(NPB + ((row - MP) >> 3)) * 3072;
        f32x4 gs[4], sh[4], v0[4];
        NORM_LOAD(v0, row);
#pragma unroll
        for (int j = 0; j < 4; ++j) { gs[j] = *((const f32x4*)g + 64 * j + lane) * (*((const f32x4*)(mp + D) + 64 * j + lane) + 1.0f); sh[j] = *((const f32x4*)mp + 64 * j + lane); }
        NORM_FINISH(v0, row, gs, sh);
    }
#undef NORM_LOAD
#undef NORM_FINISH
}

__device__ __forceinline__ void normrope8(float (&v)[8], int sub, const float* gain, const float* tabrow) {
    float ss = 0.f;
#pragma unroll
    for (int i = 0; i < 8; ++i) ss += v[i] * v[i];
    ss += __shfl_xor(ss, 1); ss += __shfl_xor(ss, 2); ss += __shfl_xor(ss, 4);
    const float rstd = rsqrtf(ss * (1.0f / 64.0f) + EPS);
    const f32x4 g0 = *(const f32x4*)(gain + sub * 8), g1 = *(const f32x4*)(gain + sub * 8 + 4);
    v[0] *= rstd * g0.x; v[1] *= rstd * g0.y; v[2] *= rstd * g0.z; v[3] *= rstd * g0.w; v[4] *= rstd * g1.x; v[5] *= rstd * g1.y; v[6] *= rstd * g1.z; v[7] *= rstd * g1.w;
    float pr[8];
#pragma unroll
    for (int i = 0; i < 8; ++i) pr[i] = __shfl_xor(v[i], 1);
    if (sub < 2) {
        const f32x4 c0 = *(const f32x4*)(tabrow), c1 = *(const f32x4*)(tabrow + 4), s0 = *(const f32x4*)(tabrow + 8), s1 = *(const f32x4*)(tabrow + 12);
        const float cs[8] = {c0.x, c0.y, c0.z, c0.w, c1.x, c1.y, c1.z, c1.w}, sn[8] = {s0.x, s0.y, s0.z, s0.w, s1.x, s1.y, s1.z, s1.w};
        const float sg = (sub == 0) ? -1.0f : 1.0f;
#pragma unroll
        for (int i = 0; i < 8; ++i) v[i] = v[i] * cs[i] + sg * pr[i] * sn[i];
    }
}

__device__ __forceinline__ s16x4 vtr(const LAS unsigned char* p) { return __builtin_bit_cast(s16x4, __builtin_amdgcn_ds_read_tr16_b64_v4i16((LAS v4i16_t*)p)); }

template <bool SAMPLE>
__device__ __forceinline__ void attn_prefetch(const bf16_t* __restrict__ proj, int row0, int head0, int lane, u32x4 (&qw)[4], u32x4 (&zw)[4]) {
    const int r32 = lane & 31, hi = lane >> 5;
    const int myrow = SAMPLE ? row0 + (r32 & 7) : row0 + r32;
    const int myhead = SAMPLE ? head0 + (r32 >> 3) : head0;
    const bf16_t* qp = proj + (size_t)myrow * PO2 + C_Q + myhead * 64 + hi * 8;
#pragma unroll
    for (int d0 = 0; d0 < 4; ++d0) qw[d0] = *(const u32x4*)(qp + d0 * 16);
#pragma unroll
    for (int it4 = 0; it4 < 4; ++it4) {
        const int qq = it4 * 8 + (lane >> 3), ch = lane & 7;
        const int orow = SAMPLE ? row0 + (qq & 7) : row0 + qq;
        const int ohead = SAMPLE ? head0 + (qq >> 3) : head0;
        zw[it4] = *(const u32x4*)(proj + (size_t)orow * PO2 + C_ZA + ohead * 64 + ch * 8);
    }
}
template <bool SAMPLE>
__device__ __forceinline__ void attn_tile32(const u32x4 (&qw)[4], const u32x4 (&zw)[4], bf16_t* __restrict__ Y, const float* __restrict__ tab, const f32x4 (&qgv)[8], const float* __restrict__ sinks,
                                            const LAS unsigned char* Kl, const LAS unsigned char* Vl, int vhalf, LAS float* wsf, LAS bf16_t* ost,
                                            int row0, int head0, int pos0, int tmin, int lane) {
    const int r32 = lane & 31, hi = lane >> 5;
    const int myhead = SAMPLE ? head0 + (r32 >> 3) : head0;
    const int mypos = SAMPLE ? pos0 + (r32 & 7) : pos0 + r32;
    float q[4][8];
#pragma unroll
    for (int d0 = 0; d0 < 4; ++d0) unpack8(qw[d0], q[d0]);
    float ss = 0.f;
#pragma unroll
    for (int d0 = 0; d0 < 4; ++d0)
#pragma unroll
        for (int i = 0; i < 8; ++i) ss += q[d0][i] * q[d0][i];
    ss += __shfl_xor(ss, 32);
    const float rstd = rsqrtf(ss * (1.0f / 64.0f) + EPS);
#pragma unroll
    for (int d0 = 0; d0 < 4; ++d0) { const f32x4 g0 = qgv[2 * d0], g1 = qgv[2 * d0 + 1];
        q[d0][0] *= rstd * g0.x; q[d0][1] *= rstd * g0.y; q[d0][2] *= rstd * g0.z; q[d0][3] *= rstd * g0.w; q[d0][4] *= rstd * g1.x; q[d0][5] *= rstd * g1.y; q[d0][6] *= rstd * g1.z; q[d0][7] *= rstd * g1.w; }
    {
        const float* tr = tab + (size_t)mypos * 16;
        const f32x4 c0 = *(const f32x4*)(tr), c1 = *(const f32x4*)(tr + 4), s0 = *(const f32x4*)(tr + 8), s1 = *(const f32x4*)(tr + 12);
        const float cs[8] = {c0.x, c0.y, c0.z, c0.w, c1.x, c1.y, c1.z, c1.w}, sn[8] = {s0.x, s0.y, s0.z, s0.w, s1.x, s1.y, s1.z, s1.w};
        const float sg = (hi == 0) ? -1.0f : 1.0f;
#pragma unroll
        for (int i = 0; i < 8; ++i) { const float pr = __shfl_xor(q[0][i], 32); q[0][i] = q[0][i] * cs[i] + sg * pr * sn[i]; }
    }
    bf16x8 qr[4];
#pragma unroll
    for (int d0 = 0; d0 < 4; ++d0) {
#pragma unroll
        for (int i = 0; i < 8; ++i) q[d0][i] *= 0.125f * LOG2E;
        qr[d0] = __builtin_bit_cast(bf16x8, pack8(q[d0])); }
    f32x16 p[5];
    const int rq = SAMPLE ? (r32 & 7) : r32;
    const int lo = rq + 1 - 4 * hi, hi_ = rq - 4 * hi;
    float mx = -1e30f;
#pragma unroll
    for (int t = 0; t < 5; ++t) {
        if (t >= tmin) {
#pragma unroll
            for (int i = 0; i < 16; ++i) p[t][i] = 0.f;
#pragma unroll
            for (int d0 = 0; d0 < 4; ++d0) { const bf16x8 kf = *(const LAS bf16x8*)(Kl + (32 * t + r32) * 144 + (16 * d0 + 8 * hi) * 2);
                p[t] = __builtin_amdgcn_mfma_f32_32x32x16_bf16(kf, qr[d0], p[t], 0, 0, 0); }
            if (t == 0) {
#pragma unroll
                for (int i = 0; i < 16; ++i) { const int kc = (i & 3) + 8 * (i >> 2); p[t][i] = (kc >= lo) ? p[t][i] : -1e30f; }
            }
            if (t == 4) {
#pragma unroll
                for (int i = 0; i < 16; ++i) { const int kc = (i & 3) + 8 * (i >> 2); p[t][i] = (kc <= hi_) ? p[t][i] : -1e30f; }
            }
        } else {
#pragma unroll
            for (int i = 0; i < 16; ++i) p[t][i] = -1e30f;
        }
#pragma unroll
        for (int i = 0; i < 16; ++i) mx = fmaxf(mx, p[t][i]);
    }
    mx = fmaxf(mx, __shfl_xor(mx, 32));
    const float sk = sinks[myhead] * LOG2E;
    mx = fmaxf(mx, sk);
    float lsum = 0.f;
    u32x4 pw[5][2];
#pragma unroll
    for (int t = 0; t < 5; ++t) {
#pragma unroll
        for (int i = 0; i < 16; ++i) { p[t][i] = __builtin_amdgcn_exp2f(p[t][i] - mx); lsum += p[t][i]; }
#pragma unroll
        for (int s = 0; s < 2; ++s) { pw[t][s].x = pk_bf16(p[t][8 * s + 0], p[t][8 * s + 1]); pw[t][s].y = pk_bf16(p[t][8 * s + 2], p[t][8 * s + 3]); pw[t][s].z = pk_bf16(p[t][8 * s + 4], p[t][8 * s + 5]); pw[t][s].w = pk_bf16(p[t][8 * s + 6], p[t][8 * s + 7]); }
    }
    lsum += __shfl_xor(lsum, 32);
    const float denom = lsum + __builtin_amdgcn_exp2f(sk - mx);
    if (hi == 0) wsf[r32] = 1.0f / denom;
    __builtin_amdgcn_sched_barrier(0);
    f32x16 o[2];
#pragma unroll
    for (int d0 = 0; d0 < 2; ++d0)
#pragma unroll
        for (int i = 0; i < 16; ++i) o[d0][i] = 0.f;
    const int i16 = lane & 15;
    const LAS unsigned char* vb = Vl + (4 * hi + (i16 >> 2)) * 64 + ((lane >> 4) & 1) * 32 + (i16 & 3) * 8;
#pragma unroll
    for (int t = 0; t < 5; ++t)
#pragma unroll
        for (int s = 0; s < 2; ++s) {
            const bf16x8 pa = __builtin_bit_cast(bf16x8, pw[t][s]);
#pragma unroll
            for (int d0 = 0; d0 < 2; ++d0) {
                const s16x4 vlo = vtr(vb + d0 * vhalf + (32 * t + 16 * s) * 64), vhi = vtr(vb + d0 * vhalf + (32 * t + 16 * s + 8) * 64);
                const bf16x8 vf = (bf16x8){vlo[0], vlo[1], vlo[2], vlo[3], vhi[0], vhi[1], vhi[2], vhi[3]};
                o[d0] = __builtin_amdgcn_mfma_f32_32x32x16_bf16(pa, vf, o[d0], 0, 0, 0);
            }
        }
    __builtin_amdgcn_sched_barrier(0);
    asm volatile("s_waitcnt lgkmcnt(0)" ::: "memory");
#pragma unroll
    for (int i = 0; i < 16; ++i) {
        const int qq = crow(i, hi);
        const float rl = wsf[qq];
#pragma unroll
        for (int d0 = 0; d0 < 2; ++d0) ost[qq * 64 + d0 * 32 + r32] = (bf16_t)(pk_bf16(o[d0][i] * rl, 0.f) & 0xffffu);
    }
    asm volatile("s_waitcnt lgkmcnt(0)" ::: "memory");
#pragma unroll
    for (int it4 = 0; it4 < 4; ++it4) {
        const int qq = it4 * 8 + (lane >> 3), ch = lane & 7;
        const int orow = SAMPLE ? row0 + (qq & 7) : row0 + qq;
        const int ohead = SAMPLE ? head0 + (qq >> 3) : head0;
        const u32x4 ow = *(const LAS u32x4*)(ost + qq * 64 + ch * 8);
        float of[8], zf[8], yv[8];
        unpack8(ow, of); unpack8(zw[it4], zf);
#pragma unroll
        for (int k = 0; k < 8; ++k) yv[k] = of[k] * zf[k];
        *(u32x4*)(Y + (size_t)orow * D + 512 + ohead * 64 + ch * 8) = pack8(yv);
    }
    asm volatile("s_waitcnt lgkmcnt(0)" ::: "memory");
}

__device__ __forceinline__ void attn_prompt_item(const Args& a, int l, int item, LAS unsigned char* lds, int tid, int lane, int wave) {
    const int kvh = item & 1, b = (item >> 1) & 31, n = item >> 6;
    const bf16_t* proj = (const bf16_t*)(a.ws + WS_PROJ); bf16_t* Y = (bf16_t*)(a.ws + WS_H);
    const float* tab = (const float*)(a.ws + WS_ROPE);
    const float* kg = a.in[13] + l * 64; const float* qg = a.in[12] + l * 64; const float* sinks = a.in[14] + l * 8;
    LAS unsigned char* Kl = lds; LAS unsigned char* Vl = lds + 36864; LAS float* wsf = (LAS float*)(lds + 36864 + 32768) + wave * 64; LAS bf16_t* ost = (LAS bf16_t*)(lds + 73728 + wave * 4096);
    const int headw = kvh * 4 + (wave >> 1), qt0 = (wave & 1) * 2, rowq0 = n * LP + b * 128 + qt0 * 32;
    u32x4 qw0[4], zw0[4], qw1[4], zw1[4];
    attn_prefetch<false>(proj, rowq0, headw, lane, qw0, zw0); attn_prefetch<false>(proj, rowq0 + 32, headw, lane, qw1, zw1);
    f32x4 qgv[8];
#pragma unroll
    for (int d0 = 0; d0 < 4; ++d0) { qgv[2 * d0] = *(const f32x4*)(qg + d0 * 16 + (lane >> 5) * 8); qgv[2 * d0 + 1] = *(const f32x4*)(qg + d0 * 16 + (lane >> 5) * 8 + 4); }
    const int sub = tid & 7, rl = tid >> 3;
    u32x4 kws[4], vws[4];
#pragma unroll
    for (int pass = 0; pass < 4; ++pass) {
        const int j = pass * 64 + rl; const int pos = 128 * (b - 1) + j; const int posc = pos < 0 ? 0 : pos;
        const size_t row = (size_t)n * LP + posc;
        kws[pass] = *(const u32x4*)(proj + row * PO2 + C_K + kvh * 64 + sub * 8);
        vws[pass] = *(const u32x4*)(proj + row * PO2 + C_V + kvh * 64 + sub * 8);
    }
#pragma unroll
    for (int pass = 0; pass < 4; ++pass) {
        const int j = pass * 64 + rl; const int pos = 128 * (b - 1) + j; const int posc = pos < 0 ? 0 : pos;
        const u32x4 kw = kws[pass], vw = vws[pass];
        float kf[8]; unpack8(kw, kf);
        normrope8(kf, sub, kg, tab + (size_t)posc * 16);
        *(LAS u32x4*)(Kl + j * 144 + sub * 16) = pack8(kf);
        *(LAS u32x4*)(Vl + (sub >> 2) * 16384 + j * 64 + (sub & 3) * 16) = vw;
        if (b == 31 && j >= 128) {
            float* okp = a.out + O_KP + (((size_t)(l * NPB + n) * 128 + (j - 128)) * 2 + kvh) * 64 + sub * 8;
            float* ovp = a.out + O_VP + (((size_t)(l * NPB + n) * 128 + (j - 128)) * 2 + kvh) * 64 + sub * 8;
            float vf[8]; unpack8(vw, vf);
            *(f32x4*)okp = (f32x4){kf[0], kf[1], kf[2], kf[3]}; *(f32x4*)(okp + 4) = (f32x4){kf[4], kf[5], kf[6], kf[7]};
            *(f32x4*)ovp = (f32x4){vf[0], vf[1], vf[2], vf[3]}; *(f32x4*)(ovp + 4) = (f32x4){vf[4], vf[5], vf[6], vf[7]};
        }
    }
    __syncthreads();
    attn_tile32<false>(qw0, zw0, Y, tab, qgv, sinks, Kl + 32 * qt0 * 144, Vl + 32 * qt0 * 64, 16384, wsf, ost, rowq0, headw, b * 128 + qt0 * 32, (b == 0) ? 4 - qt0 : 0, lane);
    attn_tile32<false>(qw1, zw1, Y, tab, qgv, sinks, Kl + 32 * (qt0 + 1) * 144, Vl + 32 * (qt0 + 1) * 64, 16384, wsf, ost, rowq0 + 32, headw, b * 128 + qt0 * 32 + 32, (b == 0) ? 3 - qt0 : 0, lane);
    __syncthreads();
}

__device__ __forceinline__ void attn_sample_item(const Args& a, int l, int n, LAS unsigned char* lds, int tid, int lane, int wave) {
    const bf16_t* proj = (const bf16_t*)(a.ws + WS_PROJ); bf16_t* Y = (bf16_t*)(a.ws + WS_H);
    const float* tab = (const float*)(a.ws + WS_ROPE);
    const float* kg = a.in[13] + l * 64; const float* qg = a.in[12] + l * 64; const float* sinks = a.in[14] + l * 8;
    constexpr int KH = 160 * 144  , VOFF = 2 * KH  , VH = 160 * 64  ;
    LAS float* wsf = (LAS float*)(lds + 98304) + wave * 64; LAS bf16_t* ost = (LAS bf16_t*)(lds + 102400 + wave * 4096);
    const float* ck = a.in[5] + (size_t)(l * NSB + n) * 128 * 128; const float* cv = a.in[6] + (size_t)(l * NSB + n) * 128 * 128;
    float* oks = a.out + O_KS + (size_t)(l * NSB + n) * 128 * 128; float* ovs = a.out + O_VS + (size_t)(l * NSB + n) * 128 * 128;
    const int c16 = tid & 15, kvh = c16 >> 3, sub = c16 & 7;
    u32x4 qws[4], zws[4];
    if (wave < 2) attn_prefetch<true>(proj, MP + n * LS, wave * 4, lane, qws, zws);
    f32x4 kc[4][2], vc[4][2];
#pragma unroll
    for (int pass = 0; pass < 4; ++pass) {
        const int r = pass * 32 + (tid >> 4);
        kc[pass][0] = __builtin_nontemporal_load((const f32x4*)(ck + r * 128 + c16 * 8)); kc[pass][1] = __builtin_nontemporal_load((const f32x4*)(ck + r * 128 + c16 * 8 + 4));
        vc[pass][0] = __builtin_nontemporal_load((const f32x4*)(cv + r * 128 + c16 * 8)); vc[pass][1] = __builtin_nontemporal_load((const f32x4*)(cv + r * 128 + c16 * 8 + 4));
    }
#pragma unroll
    for (int pass = 0; pass < 4; ++pass) {
        const int r = pass * 32 + (tid >> 4);
        const f32x4 k0 = kc[pass][0], k1 = kc[pass][1], v0 = vc[pass][0], v1 = vc[pass][1];
        u32x4 kw; kw.x = pk_bf16(k0.x, k0.y); kw.y = pk_bf16(k0.z, k0.w); kw.z = pk_bf16(k1.x, k1.y); kw.w = pk_bf16(k1.z, k1.w);
        u32x4 vw; vw.x = pk_bf16(v0.x, v0.y); vw.y = pk_bf16(v0.z, v0.w); vw.z = pk_bf16(v1.x, v1.y); vw.w = pk_bf16(v1.z, v1.w);
        *(LAS u32x4*)(lds + kvh * KH + r * 144 + sub * 16) = kw;
        *(LAS u32x4*)(lds + VOFF + kvh * 2 * VH + (sub >> 2) * VH + r * 64 + (sub & 3) * 16) = vw;
        if (r >= 8) { float* pk = oks + (r - 8) * 128 + c16 * 8; float* pv = ovs + (r - 8) * 128 + c16 * 8;
            __builtin_nontemporal_store(k0, (f32x4*)pk); __builtin_nontemporal_store(k1, (f32x4*)(pk + 4)); __builtin_nontemporal_store(v0, (f32x4*)pv); __builtin_nontemporal_store(v1, (f32x4*)(pv + 4)); }
    }
    if (wave < 2) {
        const int t = tid >> 4; const size_t row = (size_t)MP + n * LS + t;
        const u32x4 kw = *(const u32x4*)(proj + row * PO2 + C_K + kvh * 64 + sub * 8);
        const u32x4 vw = *(const u32x4*)(proj + row * PO2 + C_V + kvh * 64 + sub * 8);
        float kf[8]; unpack8(kw, kf);
        normrope8(kf, sub, kg, tab + (size_t)(LP + t) * 16);
        *(LAS u32x4*)(lds + kvh * KH + (128 + t) * 144 + sub * 16) = pack8(kf);
        *(LAS u32x4*)(lds + VOFF + kvh * 2 * VH + (sub >> 2) * VH + (128 + t) * 64 + (sub & 3) * 16) = vw;
        float vf[8]; unpack8(vw, vf);
        float* pk = oks + (120 + t) * 128 + c16 * 8; float* pv = ovs + (120 + t) * 128 + c16 * 8;
        *(f32x4*)pk = (f32x4){kf[0], kf[1], kf[2], kf[3]}; *(f32x4*)(pk + 4) = (f32x4){kf[4], kf[5], kf[6], kf[7]};
        *(f32x4*)pv = (f32x4){vf[0], vf[1], vf[2], vf[3]}; *(f32x4*)(pv + 4) = (f32x4){vf[4], vf[5], vf[6], vf[7]};
    }
    for (int e = tid; e < 2 * 216 + 4 * 96; e += 512) {
        const u32x4 z = {0u, 0u, 0u, 0u};
        if (e < 432) { const int h = e / 216, c = e % 216; *(LAS u32x4*)(lds + h * KH + 136 * 144 + c * 16) = z; }
        else { const int e2 = e - 432, im = e2 / 96, c = e2 % 96; *(LAS u32x4*)(lds + VOFF + im * VH + 136 * 64 + c * 16) = z; }
    }
    __syncthreads();
    if (wave < 2) {
        const int h = wave;
        f32x4 qgv[8];
#pragma unroll
        for (int d0 = 0; d0 < 4; ++d0) { qgv[2 * d0] = *(const f32x4*)(qg + d0 * 16 + (lane >> 5) * 8); qgv[2 * d0 + 1] = *(const f32x4*)(qg + d0 * 16 + (lane >> 5) * 8 + 4); }
        attn_tile32<true>(qws, zws, Y, tab, qgv, sinks, lds + h * KH, lds + VOFF + h * 2 * VH, VH, wsf, ost, MP + n * LS, h * 4, LP, 0, lane);
    }
    __syncthreads();
}

__device__ __forceinline__ void conv_item(const Args& a, int l, int it, int lane, int wave) {
    const bf16_t* proj = (const bf16_t*)(a.ws + WS_PROJ); bf16_t* Y = (bf16_t*)(a.ws + WS_H);
    const int t0 = it * 64 + wave * 8, ch = lane * 8;
    const float* cw = a.in[11] + (size_t)l * 3 * 512 + ch;
    float w0[8], w1[8], w2[8];
    { const f32x4 a0 = *(const f32x4*)(cw), a1 = *(const f32x4*)(cw + 4), b0 = *(const f32x4*)(cw + 512), b1 = *(const f32x4*)(cw + 516), c0 = *(const f32x4*)(cw + 1024), c1 = *(const f32x4*)(cw + 1028);
      w0[0] = a0.x; w0[1] = a0.y; w0[2] = a0.z; w0[3] = a0.w; w0[4] = a1.x; w0[5] = a1.y; w0[6] = a1.z; w0[7] = a1.w;
      w1[0] = b0.x; w1[1] = b0.y; w1[2] = b0.z; w1[3] = b0.w; w1[4] = b1.x; w1[5] = b1.y; w1[6] = b1.z; w1[7] = b1.w;
      w2[0] = c0.x; w2[1] = c0.y; w2[2] = c0.z; w2[3] = c0.w; w2[4] = c1.x; w2[5] = c1.y; w2[6] = c1.z; w2[7] = c1.w; }
    u32x4 uw[8], gw[8];
#pragma unroll
    for (int i = 0; i < 8; ++i) { uw[i] = *(const u32x4*)(proj + (size_t)(t0 + i) * PO2 + C_U + ch); gw[i] = *(const u32x4*)(proj + (size_t)(t0 + i) * PO2 + C_GZ + ch); }
    float u2[8], u1[8];
    if (t0 < MP) {
        if ((t0 & (LP - 1)) == 0) {
#pragma unroll
            for (int i = 0; i < 8; ++i) { u2[i] = 0.f; u1[i] = 0.f; }
        } else {
            unpack8(*(const u32x4*)(proj + (size_t)(t0 - 2) * PO2 + C_U + ch), u2);
            unpack8(*(const u32x4*)(proj + (size_t)(t0 - 1) * PO2 + C_U + ch), u1);
        }
    } else {
        const int n = (t0 - MP) >> 3;
        const float* sc = a.in[4] + ((size_t)(l * NSB + n) * 2) * 512 + ch;
        const f32x4 a0 = *(const f32x4*)(sc), a1 = *(const f32x4*)(sc + 4), b0 = *(const f32x4*)(sc + 512), b1 = *(const f32x4*)(sc + 516);
        u2[0] = a0.x; u2[1] = a0.y; u2[2] = a0.z; u2[3] = a0.w; u2[4] = a1.x; u2[5] = a1.y; u2[6] = a1.z; u2[7] = a1.w;
        u1[0] = b0.x; u1[1] = b0.y; u1[2] = b0.z; u1[3] = b0.w; u1[4] = b1.x; u1[5] = b1.y; u1[6] = b1.z; u1[7] = b1.w;
    }
#pragma unroll
    for (int i = 0; i < 8; ++i) {
        float u0[8], gz[8], yv[8];
        unpack8(uw[i], u0); unpack8(gw[i], gz);
#pragma unroll
        for (int k = 0; k < 8; ++k) { yv[k] = gz[k] * (w0[k] * u2[k] + w1[k] * u1[k] + w2[k] * u0[k]); u2[k] = u1[k]; u1[k] = u0[k]; }
        *(u32x4*)(Y + (size_t)(t0 + i) * D + ch) = pack8(yv);
    }
    float* oc = nullptr;
    if (t0 < MP) { if ((t0 & (LP - 1)) == LP - 8) oc = a.out + O_CP + ((size_t)(l * NPB + (t0 >> 12)) * 2) * 512 + ch; }
    else oc = a.out + O_CS + ((size_t)(l * NSB + ((t0 - MP) >> 3)) * 2) * 512 + ch;
    if (oc) { *(f32x4*)oc = (f32x4){u2[0], u2[1], u2[2], u2[3]}; *(f32x4*)(oc + 4) = (f32x4){u2[4], u2[5], u2[6], u2[7]};
              *(f32x4*)(oc + 512) = (f32x4){u1[0], u1[1], u1[2], u1[3]}; *(f32x4*)(oc + 516) = (f32x4){u1[4], u1[5], u1[6], u1[7]}; }
}

__device__ __forceinline__ void p_mixer(const Args& a, int l, LAS unsigned char* lds, int tid, int lane, int wave, int bid, int G) {
    constexpr int N_AP = NPB * 32 * 2, N_AS = NSB, N_CV = M / 64;
    unsigned* head = (unsigned*)(a.ws + WS_BAR) + QUEUE_WORD + 64 * l;
    volatile LAS unsigned* slot = (volatile LAS unsigned*)(lds + 131072 + 128);
    const bool qfirst = ((bid >> 3) & 1) != 0;
    bool prompt_done = false, queue_empty = false; int pulled = 0;
#pragma unroll 1
    for (;;) {
        if (!prompt_done && (!qfirst || pulled >= 1 || queue_empty)) {
#pragma unroll 1
            for (int it = bid; it < N_AP; it += G) { asm volatile("" : "+v"(tid)); lane = tid & 63; attn_prompt_item(a, l, it, lds, tid, lane, wave); }
            prompt_done = true; continue;
        }
        if (queue_empty) break;
        if (threadIdx.x == 0) slot[0] = __hip_atomic_fetch_add(head, 1u, __ATOMIC_RELAXED, __HIP_MEMORY_SCOPE_AGENT);
        __syncthreads();
        const int q = (int)slot[0];
        __syncthreads();
        if (q >= N_AS + N_CV) { queue_empty = true; continue; }
        ++pulled;
        asm volatile("" : "+v"(tid)); lane = tid & 63;
        if (q < N_AS) attn_sample_item(a, l, q, lds, tid, lane, wave);
        else conv_item(a, l, q - N_AS, lane, wave);
    }
}

__device__ __forceinline__ void g2_sample_tile(const bf16_t* __restrict__ Y, const bf16_t* __restrict__ Wt, const float* xs  , const bf16_t* xbs  , float* outs  , bf16_t* outbs  , const float* __restrict__ gate,
                                               LAS unsigned char* lds, int tile, int tid, int lane, int wave) {
    const int row0 = (tile >> 4) * 64, col0 = (tile & 15) * 64, m = lane & 31, kq = lane >> 5;
    f32x16 acc[2][2];
#pragma unroll
    for (int i2 = 0; i2 < 2; ++i2)
#pragma unroll
        for (int j2 = 0; j2 < 2; ++j2)
#pragma unroll
            for (int i = 0; i < 16; ++i) acc[i2][j2][i] = 0.f;
    const bf16_t* ap = Y + (size_t)(MP + row0 + m) * D + wave * 128 + kq * 8;
    const bf16_t* bp = Wt + (size_t)(col0 + m) * D + wave * 128 + kq * 8;
#pragma unroll
    for (int ks = 0; ks < 8; ++ks) {
        const bf16x8 a0 = *(const bf16x8*)(ap + ks * 16), a1 = *(const bf16x8*)(ap + 32 * D + ks * 16), b0 = *(const bf16x8*)(bp + ks * 16), b1 = *(const bf16x8*)(bp + 32 * D + ks * 16);
        acc[0][0] = __builtin_amdgcn_mfma_f32_32x32x16_bf16(a0, b0, acc[0][0], 0, 0, 0); acc[0][1] = __builtin_amdgcn_mfma_f32_32x32x16_bf16(a0, b1, acc[0][1], 0, 0, 0);
        acc[1][0] = __builtin_amdgcn_mfma_f32_32x32x16_bf16(a1, b0, acc[1][0], 0, 0, 0); acc[1][1] = __builtin_amdgcn_mfma_f32_32x32x16_bf16(a1, b1, acc[1][1], 0, 0, 0);
    }
    LAS float* slab = (LAS float*)lds + wave * 4096;
#pragma unroll
    for (int i2 = 0; i2 < 2; ++i2)
#pragma unroll
        for (int j2 = 0; j2 < 2; ++j2)
#pragma unroll
            for (int i = 0; i < 16; ++i) slab[(32 * i2 + crow(i, kq)) * 64 + 32 * j2 + m] = acc[i2][j2][i];
    __syncthreads();
    const int r = tid >> 3, c8 = (tid & 7) * 8;
    f32x4 s0 = {0.f, 0.f, 0.f, 0.f}, s1 = {0.f, 0.f, 0.f, 0.f};
#pragma unroll
    for (int w = 0; w < 8; ++w) { const LAS float* sp = (const LAS float*)lds + w * 4096 + r * 64 + c8; s0 += *(const LAS f32x4*)sp; s1 += *(const LAS f32x4*)(sp + 4); }
    const int srow = row0 + r, nidx = NPB + (srow >> 3);
    const size_t ro = (size_t)srow * D + col0 + c8; const float* gp = gate + (size_t)nidx * 3072 + col0 + c8;
    const f32x4 g0 = *(const f32x4*)gp, g1 = *(const f32x4*)(gp + 4);
    f32x4 x0, x1;
    if (xs) { x0 = *(const f32x4*)(xs + ro); x1 = *(const f32x4*)(xs + ro + 4); }
    else { const u32x4 w = __builtin_nontemporal_load((const u32x4*)(xbs + ro));
        x0 = (f32x4){__uint_as_float(w.x << 16), __uint_as_float(w.x & 0xffff0000u), __uint_as_float(w.y << 16), __uint_as_float(w.y & 0xffff0000u)};
        x1 = (f32x4){__uint_as_float(w.z << 16), __uint_as_float(w.z & 0xffff0000u), __uint_as_float(w.w << 16), __uint_as_float(w.w & 0xffff0000u)}; }
    const f32x4 v0 = x0 + g0 * s0, v1 = x1 + g1 * s1;
    if (outbs) { u32x4 w; w.x = pk_bf16(v0[0], v0[1]); w.y = pk_bf16(v0[2], v0[3]); w.z = pk_bf16(v1[0], v1[1]); w.w = pk_bf16(v1[2], v1[3]); *(u32x4*)(outbs + ro) = w; }
    else { *(f32x4*)(outs + ro) = v0; *(f32x4*)(outs + ro + 4) = v1; }
    __syncthreads();
}

#define XB_TMO      128
#define XB_XCNT(j)  (256  + 64 * (j))
#define XB_XSUB(j)  (1280 + 64 * (j))
#define XB_XGEN(j)  (2304 + 64 * (j))
#define XB_TOP      3328
#define XB_TOPGEN   3392
#define XCD_BAR_WORDS 3456
#define XB_SPIN_CAP (1u << 18)

__device__ __forceinline__ unsigned xb_ld(unsigned* p)              { return __hip_atomic_load(p, __ATOMIC_RELAXED, __HIP_MEMORY_SCOPE_AGENT); }
__device__ __forceinline__ unsigned xb_add(unsigned* p, unsigned v) { return __hip_atomic_fetch_add(p, v, __ATOMIC_RELAXED, __HIP_MEMORY_SCOPE_AGENT); }
__device__ __forceinline__ unsigned xb_xcc_id() { return (unsigned)__builtin_amdgcn_s_getreg((3 << 11) | 20) & 0xFu; }
#define XB_SPIN(cond, bar) do { unsigned _sp = 0; while (cond) { __builtin_amdgcn_s_sleep(1); \
    if ((++_sp & 255u) == 0u) { if (xb_ld(&(bar)[XB_TMO])) break; if (_sp > XB_SPIN_CAP) { atomicAdd(&(bar)[XB_TMO], 1u); break; } } } } while (0)

struct XcdBarrier {
    unsigned* bar; unsigned x;
    volatile LAS unsigned* st;
};

__device__ __forceinline__ XcdBarrier xcd_barrier_post(unsigned* bar, volatile LAS unsigned* st) {
    XcdBarrier b; b.bar = bar; b.x = xb_xcc_id(); b.st = st;
    if (threadIdx.x == 0) (void)xb_add(&bar[XB_XCNT(b.x)], 1u);
    return b;
}
__device__ __forceinline__ void xcd_barrier_complete(unsigned* bar, unsigned x, unsigned& nloc, unsigned& nx) {
    const unsigned G = gridDim.x * gridDim.y * gridDim.z;
    unsigned sum, cnt, mine, sp = 0u;
    for (;;) {
        sum = 0u; cnt = 0u; mine = 0u;
#pragma unroll
        for (unsigned j = 0; j < 16; ++j) { const unsigned c = xb_ld(&bar[XB_XCNT(j)]); sum += c; cnt += (c > 0u) ? 1u : 0u; mine = (j == x) ? c : mine; }
        if (sum == G) break;
        __builtin_amdgcn_s_sleep(1);
        if ((++sp & 255u) == 0u) { if (xb_ld(&bar[XB_TMO])) break; if (sp > XB_SPIN_CAP) { atomicAdd(&bar[XB_TMO], 1u); break; } }
    }
    nloc = mine > 0u ? mine : 1u; nx = cnt > 0u ? cnt : 1u;
}

__device__ __forceinline__ void xcd_barrier(const XcdBarrier& b) {
    asm volatile("s_waitcnt vmcnt(0)" ::: "memory");
    __syncthreads();
    if (threadIdx.x == 0) {
        unsigned* bar = b.bar;
        __builtin_amdgcn_s_waitcnt(0);
        unsigned nloc = b.st[0], nx = b.st[1];
        if (nloc == 0u) { xcd_barrier_complete(bar, b.x, nloc, nx); b.st[0] = nloc; b.st[1] = nx; }
        const unsigned old = xb_add(&bar[XB_XSUB(b.x)], 1u);
        const unsigned gen = old / nloc;
        if (old + 1u == (gen + 1u) * nloc) {
            __builtin_amdgcn_fence(__ATOMIC_RELEASE, "agent");
            asm volatile("s_waitcnt vmcnt(0)" ::: "memory");
            const unsigned og = xb_add(&bar[XB_TOP], 1u);
            const unsigned tg = og / nx;
            if (og + 1u == (tg + 1u) * nx) xb_add(&bar[XB_TOPGEN], 1u);
            else XB_SPIN(xb_ld(&bar[XB_TOPGEN]) == tg, bar);
            __builtin_amdgcn_fence(__ATOMIC_ACQUIRE, "agent");
            xb_add(&bar[XB_XGEN(b.x)], 1u);
            asm volatile("s_waitcnt vmcnt(0)" ::: "memory");
        } else {
            XB_SPIN(xb_ld(&bar[XB_XGEN(b.x)]) == gen, bar);
            __builtin_amdgcn_fence(__ATOMIC_ACQUIRE, "agent");
            asm volatile("s_waitcnt vmcnt(0)" ::: "memory");
        }
    }
    __syncthreads();
}

__global__ void __launch_bounds__(512, 2) fwd_megakernel(Args a) {
    extern __shared__ __attribute__((aligned(16))) unsigned char lds_raw[];
    LAS unsigned char* lds = (LAS unsigned char*)lds_raw;
    cg::grid_group grid = cg::this_grid();
    const int bid = blockIdx.x, G = gridDim.x;
    if (threadIdx.x < 64) ((LAS unsigned*)(lds + 131072))[threadIdx.x] = 0u;
    __syncthreads();
    (void)xcd_barrier_post((unsigned*)(a.ws + WS_BAR), (volatile LAS unsigned*)(lds + 131072) + 8);
#define GRID_BARRIER() do { XcdBarrier xb_; xb_.bar = (unsigned*)(a.ws + WS_BAR); xb_.x = xb_xcc_id(); xb_.st = (volatile LAS unsigned*)(lds + 131072) + 8; xcd_barrier(xb_); } while (0)
#define FRESH_TID() int tid = threadIdx.x; asm volatile("" : "+v"(tid)); const int lane = tid & 63, wave = __builtin_amdgcn_readfirstlane(tid >> 6)
    if (a.ws == nullptr) grid.sync();
    { FRESH_TID(); p0_phase(a, lds, tid, lane, wave, bid, G); }
    GRID_BARRIER();
#pragma unroll 1
    for (int l = 0; l < 2; ++l) {
        { FRESH_TID(); (void)tid; p_norm(a, l, lane, wave, bid, G); }
#if DUP == 2
        { FRESH_TID(); (void)tid; p_norm(a, l, lane, wave, bid, G); }
#endif
        GRID_BARRIER();
        {
            pg8::Gemm g{(const bf16_t*)(a.ws + WS_H), (const bf16_t*)(a.ws + WS_WIN) + (size_t)l * PO * D, M, PO, D}; pg8::StaticOrder S; S.init(M, PO, G, bid);
            pg8::EpiProj E{(bf16_t*)(a.ws + WS_PROJ)};
            pg8::gemm_phase<pg8::EpiProj, pg8::StaticOrder, true, true>(lds, g, S, E);
#if DUP == 3
            pg8::gemm_phase<pg8::EpiProj, pg8::StaticOrder, true, true>(lds, g, S, E);
#endif
            constexpr int N_UNITS = (M / 256) * (PO / 256), N_FULL = N_UNITS % 256;
            if (l == 0) { if (G == 256 && bid >= N_FULL) { FRESH_TID(); (void)tid; transposes_layer(a, 1, lds, lane, wave, bid - N_FULL, 256 - N_FULL); }
                          else if (G != 256) { FRESH_TID(); (void)tid; transposes_layer(a, 1, lds, lane, wave, bid, G); } }
        }
        GRID_BARRIER();
        { FRESH_TID(); p_mixer(a, l, lds, tid, lane, wave, bid, G); }
#if DUP == 4
        { FRESH_TID(); p_mixer(a, l, lds, tid, lane, wave, bid, G); }
#endif
        GRID_BARRIER();
        {
            pg8::Gemm g{(const bf16_t*)(a.ws + WS_H), (const bf16_t*)(a.ws + WS_WOUT) + (size_t)l * D * D, MP, D, D}; pg8::StaticOrder S; S.init(MP, D, G, bid);
            const float* gate = (const float*)(a.ws + WS_MOD) + (size_t)l * NMOD * 3072 + 2048;
            bf16_t* XB = (bf16_t*)(a.ws + WS_XB);
            const bf16_t* XBase = (const bf16_t*)(a.ws + (l == 0 ? WS_XB0 : WS_XB));
            pg8::EpiGate E{nullptr, XBase, a.out, XB, gate, l == 0};
            const bool small_first = ((bid >> 3) & 1) != 0;
#pragma unroll 1
            for (int step = 0; step < 2; ++step) {
                if ((step == 0) == small_first) { FRESH_TID();
                    for (int t = bid; t < 256; t += G) g2_sample_tile((const bf16_t*)(a.ws + WS_H), (const bf16_t*)(a.ws + WS_WOUT) + (size_t)l * D * D, nullptr, XBase + (size_t)MP * D, a.out + (size_t)MP * D, l == 0 ? XB + (size_t)MP * D : nullptr, gate, lds, t, tid, lane, wave);
                } else {
                    pg8::gemm_phase<pg8::EpiGate, pg8::StaticOrder, true, true>(lds, g, S, E);
                }
            }
        }
        if (l == 0) GRID_BARRIER();
    }
}

extern "C" void kernel_launch(void* const* d_in, const int* in_sizes, int n_in, void* d_out, int out_size, void* d_ws, size_t ws_size, hipStream_t stream) {
    static int grid_blocks = 0;
    if (grid_blocks == 0) {
        if (n_in != 16 || out_size != (int)O_END || ws_size < WS_END) { fprintf(stderr, "kernel_launch: unexpected shapes n_in %d out %d ws %zu\n", n_in, out_size, ws_size); grid_blocks = -1; return; }
        int dev = 0, cus = 0, per_cu = 0;
        hipGetDevice(&dev);
        hipDeviceGetAttribute(&cus, hipDeviceAttributeMultiprocessorCount, dev);
        hipFuncSetAttribute((const void*)fwd_megakernel, hipFuncAttributeMaxDynamicSharedMemorySize, LDS_BYTES);
        hipOccupancyMaxActiveBlocksPerMultiprocessor(&per_cu, (const void*)fwd_megakernel, 512, LDS_BYTES);
        if (per_cu < 1) { fprintf(stderr, "kernel_launch: occupancy query says %d blocks per CU\n", per_cu); per_cu = 1; }
        if (per_cu > 1) per_cu = 1;
        grid_blocks = cus * per_cu;
    }
    if (grid_blocks < 0) return;
    Args a{};
    for (int i = 0; i < 16; ++i) a.in[i] = (const float*)d_in[i];
    a.out = (float*)d_out; a.ws = (unsigned char*)d_ws;
    if (hipMemsetAsync((char*)d_ws + WS_BAR, 0, BAR_BYTES, stream) != hipSuccess) { fprintf(stderr, "kernel_launch: memset of the barrier words failed\n"); return; }
    void* args[] = {&a};
    hipError_t e = hipLaunchCooperativeKernel((const void*)fwd_megakernel, dim3(grid_blocks), dim3(512), args, LDS_BYTES, stream);
    if (e != hipSuccess) fprintf(stderr, "cooperative launch failed: %s (grid %d)\n", hipGetErrorString(e), grid_blocks);
}
```
